# Optimizing an MI355X kernel written in HIP

```python
import math
import jax, jax.numpy as jnp
from jax import lax
import numpy as np

D_MODEL = 1024
BATCH = 4
SEQ = 8192
DEPTH = 2

N_META = 16
D_RNN = D_MODEL
LRU_HEADS = 16
LRU_HEAD_DIM = D_RNN // LRU_HEADS
CONV_A = 4
LRU_C = 8.0
D_CONV = D_MODEL
CONV_B = 3
N_GROUPS = 4
EXPERTS_PER_GROUP = 8
N_EXPERTS = N_GROUPS * EXPERTS_PER_GROUP
TOP_K = 2
D_EXPERT = D_MODEL // 2
BLK = 128
N_MIXERS = 2
N_A_LAYERS = (DEPTH + 1) // 2
N_B_LAYERS = DEPTH // 2
ALPHA = (2.0 * DEPTH) ** 0.25
BETA = (8.0 * DEPTH) ** -0.25
LN_EPS = 1e-5

kernel_name = "hybrid_rglru_shortconv_hmoe_deepnorm"


def layer_norm(x, g, b):
    xf = x.astype(jnp.float32)
    mu = jnp.mean(xf, axis=-1, keepdims=True)
    var = jnp.mean(jnp.square(xf - mu), axis=-1, keepdims=True)
    y = (xf - mu) * lax.rsqrt(var + LN_EPS) * g.astype(jnp.float32) + b.astype(jnp.float32)
    return y.astype(x.dtype)


def causal_depthwise_conv(x, w):
    K, C = w.shape
    return lax.conv_general_dilated(
        x, w[:, None, :].astype(x.dtype), window_strides=(1,), padding=[(K - 1, 0)],
        dimension_numbers=("NWC", "WIO", "NWC"), feature_group_count=C)


def _linear_recurrence_combine(c1, c2):
    a1, b1 = c1
    a2, b2 = c2
    return a1 * a2, a2 * b1 + b2


def rglru_mixer(h, w_in, conv_w, conv_b, w_a, b_a, w_i, b_i, lam, w_out):
    Bsz, S, _ = h.shape
    u = h @ w_in
    y_br = jax.nn.gelu(u[..., :D_RNN])
    xc = causal_depthwise_conv(u[..., D_RNN:], conv_w) + conv_b
    xh = xc.reshape(Bsz, S, LRU_HEADS, LRU_HEAD_DIM)
    r = jax.nn.sigmoid(jnp.einsum("bshd,hde->bshe", xh, w_a).reshape(Bsz, S, D_RNN) + b_a)
    gi = jax.nn.sigmoid(jnp.einsum("bshd,hde->bshe", xh, w_i).reshape(Bsz, S, D_RNN) + b_i)
    log_a = -LRU_C * r.astype(jnp.float32) * jax.nn.softplus(-lam.astype(jnp.float32))
    a = jnp.exp(log_a)
    mult = jnp.sqrt(-jnp.expm1(2.0 * log_a))
    b = mult * (gi * xc).astype(jnp.float32)
    _, hs = lax.associative_scan(_linear_recurrence_combine, (a, b), axis=1)
    return (hs.astype(h.dtype) * y_br) @ w_out


def shortconv_mixer(h, w_in, conv_w, w_out):
    u = h @ w_in
    bg = u[..., :D_CONV]
    cg = u[..., D_CONV:2 * D_CONV]
    v = u[..., 2 * D_CONV:]
    zc = causal_depthwise_conv(cg * v, conv_w)
    return (bg * zc) @ w_out


def hierarchical_moe(h, w_group, b_group, w_expert, b_expert, w_gate, w_up, w_down):
    Bsz, S, D = h.shape
    x2 = h.reshape(Bsz * S, D)
    T = x2.shape[0]
    xf = x2.astype(jnp.float32)
    glog = xf @ w_group.astype(jnp.float32) + b_group.astype(jnp.float32)
    gprob = jax.nn.softmax(glog, axis=-1)
    g = jnp.argmax(glog, axis=-1)
    pg = jnp.take_along_axis(gprob, g[:, None], axis=1)
    elog = (xf @ w_expert.astype(jnp.float32)).reshape(T, N_GROUPS, EXPERTS_PER_GROUP) + b_expert.astype(jnp.float32)
    elog_g = jnp.take_along_axis(elog, g[:, None, None], axis=1)[:, 0]
    vals, loc = lax.top_k(elog_g, TOP_K)
    gates = pg * jax.nn.softmax(vals, axis=-1)
    eid = g[:, None] * EXPERTS_PER_GROUP + loc
    A = T * TOP_K
    eid_f = eid.reshape(-1)
    tok_f = jnp.repeat(jnp.arange(T, dtype=jnp.int32), TOP_K)
    gate_f = gates.reshape(-1)
    order = jnp.argsort(eid_f)
    eid_s = eid_f[order]
    tok_s = tok_f[order]
    gate_s = gate_f[order]
    counts = jnp.bincount(eid_f, length=N_EXPERTS)
    start = jnp.cumsum(counts) - counts
    padded = (counts + BLK - 1) // BLK * BLK
    pend = jnp.cumsum(padded)
    pstart = pend - padded
    rank = jnp.arange(A, dtype=jnp.int32) - start[eid_s]
    dest = pstart[eid_s] + rank
    n_blocks = (A + N_EXPERTS * (BLK - 1) + BLK - 1) // BLK
    P = n_blocks * BLK
    slot_tok = jnp.full((P,), T, dtype=jnp.int32).at[dest].set(tok_s)
    slot_gate = jnp.zeros((P,), jnp.float32).at[dest].set(gate_s)
    block_expert = jnp.clip(jnp.searchsorted(pend, jnp.arange(n_blocks) * BLK, side="right"), 0, N_EXPERTS - 1)
    xpad = jnp.concatenate([x2, jnp.zeros((1, D), x2.dtype)], axis=0)
    xs = xpad[slot_tok].reshape(n_blocks, BLK, D)

    def expert_block(args):
        xb, e = args
        hb = jax.nn.silu(xb @ w_gate[e]) * (xb @ w_up[e])
        return hb @ w_down[e]

    ys = lax.map(expert_block, (xs, block_expert)).reshape(P, D)
    y = jnp.zeros((T + 1, D), x2.dtype).at[slot_tok].add(ys * slot_gate[:, None].astype(ys.dtype))
    return y[:T].reshape(Bsz, S, D)


def setup_inputs(seed: int = 0) -> dict:
    key = jax.random.key(seed)
    ks = jax.random.split(key, 24)

    def nrm(k, shape, scale):
        return jax.random.normal(k, shape, jnp.float32) * scale

    u = jax.random.uniform(ks[10], (N_A_LAYERS, D_RNN), jnp.float32, 0.9, 0.999)
    a0 = u ** (1.0 / LRU_C)
    lru_lambda = jnp.log(a0) - jnp.log1p(-a0)
    return {
        "x": nrm(ks[0], (BATCH, SEQ, D_MODEL), 1.0),
        "meta_tokens": nrm(ks[1], (N_META, D_MODEL), 1.0),
        "lru_w_in": nrm(ks[2], (N_A_LAYERS, D_MODEL, 2 * D_RNN), D_MODEL ** -0.5),
        "lru_conv_w": nrm(ks[3], (N_A_LAYERS, CONV_A, D_RNN), CONV_A ** -0.5),
        "lru_conv_b": nrm(ks[4], (N_A_LAYERS, D_RNN), 0.01),
        "lru_w_a": nrm(ks[5], (N_A_LAYERS, LRU_HEADS, LRU_HEAD_DIM, LRU_HEAD_DIM), LRU_HEAD_DIM ** -0.5),
        "lru_b_a": nrm(ks[6], (N_A_LAYERS, D_RNN), 0.01),
        "lru_w_i": nrm(ks[7], (N_A_LAYERS, LRU_HEADS, LRU_HEAD_DIM, LRU_HEAD_DIM), LRU_HEAD_DIM ** -0.5),
        "lru_b_i": nrm(ks[8], (N_A_LAYERS, D_RNN), 0.01),
        "lru_lambda": lru_lambda,
        "lru_w_out": nrm(ks[9], (N_A_LAYERS, D_RNN, D_MODEL), BETA * D_RNN ** -0.5),
        "sc_w_in": nrm(ks[11], (N_B_LAYERS, D_MODEL, 3 * D_CONV), D_MODEL ** -0.5),
        "sc_conv_w": nrm(ks[12], (N_B_LAYERS, CONV_B, D_CONV), CONV_B ** -0.5),
        "sc_w_out": nrm(ks[13], (N_B_LAYERS, D_CONV, D_MODEL), BETA * D_CONV ** -0.5),
        "moe_w_group": nrm(ks[14], (DEPTH, D_MODEL, N_GROUPS), D_MODEL ** -0.5),
        "moe_b_group": nrm(ks[15], (DEPTH, N_GROUPS), 0.01),
        "moe_w_expert": nrm(ks[16], (DEPTH, D_MODEL, N_EXPERTS), D_MODEL ** -0.5),
        "moe_b_expert": nrm(ks[17], (DEPTH, N_GROUPS, EXPERTS_PER_GROUP), 0.01),
        "moe_w_gate": nrm(ks[18], (DEPTH, N_EXPERTS, D_MODEL, D_EXPERT), D_MODEL ** -0.5),
        "moe_w_up": nrm(ks[19], (DEPTH, N_EXPERTS, D_MODEL, D_EXPERT), D_MODEL ** -0.5),
        "moe_w_down": nrm(ks[20], (DEPTH, N_EXPERTS, D_EXPERT, D_MODEL), BETA * D_EXPERT ** -0.5),
        "ln_g": 1.0 + nrm(ks[21], (DEPTH, 2, D_MODEL), 0.02),
        "ln_b": nrm(ks[22], (DEPTH, 2, D_MODEL), 0.02),
    }


def reference(x, meta_tokens, lru_w_in, lru_conv_w, lru_conv_b, lru_w_a, lru_b_a, lru_w_i, lru_b_i,
              lru_lambda, lru_w_out, sc_w_in, sc_conv_w, sc_w_out, moe_w_group, moe_b_group,
              moe_w_expert, moe_b_expert, moe_w_gate, moe_w_up, moe_w_down, ln_g, ln_b):
    Bsz = x.shape[0]
    meta = jnp.broadcast_to(meta_tokens.astype(x.dtype)[None], (Bsz, N_META, D_MODEL))
    h = jnp.concatenate([meta, x], axis=1)
    for i in range(DEPTH):
        j = i // N_MIXERS
        if i % N_MIXERS == 0:
            mixed = rglru_mixer(h, lru_w_in[j], lru_conv_w[j], lru_conv_b[j], lru_w_a[j], lru_b_a[j],
                                lru_w_i[j], lru_b_i[j], lru_lambda[j], lru_w_out[j])
        else:
            mixed = shortconv_mixer(h, sc_w_in[j], sc_conv_w[j], sc_w_out[j])
        h = layer_norm(ALPHA * h + mixed, ln_g[i, 0], ln_b[i, 0])
        ffn = hierarchical_moe(h, moe_w_group[i], moe_b_group[i], moe_w_expert[i], moe_b_expert[i],
                               moe_w_gate[i], moe_w_up[i], moe_w_down[i])
        h = layer_norm(ALPHA * h + ffn, ln_g[i, 1], ln_b[i, 1])
    return h[:, N_META:]
```

```cpp
#include <hip/hip_runtime.h>
#include <cstdio>
#include <cstdint>

namespace nv {
constexpr int D = 1024, NB = 4, SEQ = 8192, NMETA = 16;
constexpr int TREAL = NB * SEQ;
constexpr int NTOK = TREAL + NMETA;
constexpr int R = 33024;
constexpr int NE = 32, NG = 4, EPG = 8, DE = 512;
constexpr int CAP = 32800;
constexpr float ALPHA = 1.41421356237309515f;
constexpr float LN_EPS = 1e-5f;
typedef float f32x16 __attribute__((ext_vector_type(16)));

__global__ void build_h(const float* __restrict__ x, const float* __restrict__ meta, float* __restrict__ h) {
    size_t i = (size_t)blockIdx.x * blockDim.x + threadIdx.x;
    size_t n4 = (size_t)R * D / 4;
    for (; i < n4; i += (size_t)gridDim.x * blockDim.x) {
        size_t r = i / (D / 4); int c4 = (int)(i % (D / 4));
        float4 v = make_float4(0.f, 0.f, 0.f, 0.f);
        if (r < TREAL) v = ((const float4*)x)[r * (D / 4) + c4];
        else if (r < NTOK) v = ((const float4*)meta)[(r - TREAL) * (D / 4) + c4];
        ((float4*)h)[i] = v;
    }
}

template <int MODE>
__global__ void __launch_bounds__(256) gemm(const float* __restrict__ A, int lda, const float* __restrict__ W, int ldw, const float* __restrict__ W2,
                                            float* __restrict__ C, int ldc, int M, int N, int K,
                                            const int* __restrict__ cnt, const int* __restrict__ list, const float* __restrict__ tokgate) {
    const int lane = threadIdx.x & 63, wid = threadIdx.x >> 6;
    const int row0 = blockIdx.y * 64 + (wid >> 1) * 32, col0 = blockIdx.x * 64 + (wid & 1) * 32;
    int e = 0, base = 0;
    if (MODE != 0) {
        e = blockIdx.z; M = cnt[e];
        for (int j = 0; j < e; ++j) base += cnt[j];
        if (blockIdx.y * 64 >= M) return;
        W += (size_t)e * K * ldw; if (MODE == 1) W2 += (size_t)e * K * ldw;
    }
    const int ri = row0 + (lane & 31);
    const bool rv = ri < M;
    long arow = ri;
    if (MODE == 1) arow = rv ? (list[e * CAP + ri] >> 1) : 0;
    if (MODE == 2) arow = base + ri;
    const float* ap = A + (size_t)arow * lda + (lane >> 5);
    const float* wp = W + (size_t)(lane >> 5) * ldw + col0 + (lane & 31);
    const float* wp2 = (MODE == 1) ? (W2 + (size_t)(lane >> 5) * ldw + col0 + (lane & 31)) : nullptr;
    f32x16 acc = {0}, acc2 = {0};
#pragma unroll 8
    for (int k = 0; k < K; k += 2) {
        float a = rv ? ap[k] : 0.f;
        float b = wp[(size_t)k * ldw];
        acc = __builtin_amdgcn_mfma_f32_32x32x2f32(a, b, acc, 0, 0, 0);
        if (MODE == 1) { float b2 = wp2[(size_t)k * ldw]; acc2 = __builtin_amdgcn_mfma_f32_32x32x2f32(a, b2, acc2, 0, 0, 0); }
    }
    const int c = col0 + (lane & 31);
#pragma unroll
    for (int r = 0; r < 16; ++r) {
        const int rr = row0 + (r & 3) + 8 * (r >> 2) + 4 * (lane >> 5);
        if (rr >= M) continue;
        if (MODE == 0) C[(size_t)rr * ldc + c] = acc[r];
        if (MODE == 1) { float g = acc[r], u = acc2[r]; float s = g / (1.f + expf(-g)); C[(size_t)(base + rr) * ldc + c] = s * u; }
        if (MODE == 2) { int li = list[e * CAP + rr]; C[(size_t)li * ldc + c] = acc[r] * tokgate[li]; }
    }
}

__device__ __forceinline__ float gelu_tanh(float x) { return 0.5f * x * (1.f + tanhf(0.7978845608028654f * (x + 0.044715f * x * x * x))); }
__device__ __forceinline__ float sigmoidf(float x) { return 1.f / (1.f + expf(-x)); }

__global__ void gelu_left(float* __restrict__ u) {
    size_t i = (size_t)blockIdx.x * blockDim.x + threadIdx.x;
    for (; i < (size_t)R * D; i += (size_t)gridDim.x * blockDim.x) { size_t r = i / D; int c = (int)(i % D); float* p = u + r * 2048 + c; *p = gelu_tanh(*p); }
}

__global__ void __launch_bounds__(64) lru_scan(float* __restrict__ u, const float* __restrict__ conv_w, const float* __restrict__ conv_b,
                                               const float* __restrict__ w_a, const float* __restrict__ b_a, const float* __restrict__ w_i, const float* __restrict__ b_i,
                                               const float* __restrict__ lam) {
    __shared__ float xs[64];
    const int b = blockIdx.x / 16, hd = blockIdx.x % 16, e = threadIdx.x, c = hd * 64 + e;
    float wa[64], wi[64];
#pragma unroll
    for (int d = 0; d < 64; ++d) { wa[d] = w_a[(hd * 64 + d) * 64 + e]; wi[d] = w_i[(hd * 64 + d) * 64 + e]; }
    const float cw0 = conv_w[0 * D + c], cw1 = conv_w[1 * D + c], cw2 = conv_w[2 * D + c], cw3 = conv_w[3 * D + c], cb = conv_b[c];
    const float ba = b_a[c], bi = b_i[c];
    const float nl = -lam[c]; const float sp = (nl > 20.f) ? nl : log1pf(expf(nl));
    float x1 = 0.f, x2 = 0.f, x3 = 0.f, h = 0.f;
    for (int p = 0; p < NMETA + SEQ; ++p) {
        const size_t row = (p < NMETA) ? (size_t)(TREAL + p) : ((size_t)b * SEQ + (p - NMETA));
        const float x0 = u[row * 2048 + 1024 + c];
        const float xc = cw0 * x3 + cw1 * x2 + cw2 * x1 + cw3 * x0 + cb;
        x3 = x2; x2 = x1; x1 = x0;
        __syncthreads();
        xs[e] = xc;
        __syncthreads();
        float ra = ba, ri = bi;
#pragma unroll
        for (int d = 0; d < 64; ++d) { const float xv = xs[d]; ra += xv * wa[d]; ri += xv * wi[d]; }
        const float r = sigmoidf(ra), gi = sigmoidf(ri);
        const float log_a = -8.0f * r * sp;
        const float a = expf(log_a);
        const float mult = sqrtf(-expm1f(2.f * log_a));
        h = a * h + mult * (gi * xc);
        if (p >= NMETA || b == 0) { float* yp = u + row * 2048 + c; *yp = h * (*yp); }
    }
}

__global__ void __launch_bounds__(256) add_ln(float* __restrict__ h, const float* __restrict__ mixed, int ldm, const float* __restrict__ g, const float* __restrict__ bb) {
    __shared__ float red[8];
    const int r = blockIdx.x, t = threadIdx.x;
    float4 hv = ((const float4*)(h + (size_t)r * D))[t];
    float4 mv = ((const float4*)(mixed + (size_t)r * ldm))[t];
    float y0 = ALPHA * hv.x + mv.x, y1 = ALPHA * hv.y + mv.y, y2 = ALPHA * hv.z + mv.z, y3 = ALPHA * hv.w + mv.w;
    float s = (y0 + y1) + (y2 + y3);
    for (int o = 1; o < 64; o <<= 1) s += __shfl_xor(s, o);
    if ((t & 63) == 0) red[t >> 6] = s;
    __syncthreads();
    const float mu = (red[0] + red[1] + red[2] + red[3]) * (1.f / D);
    y0 -= mu; y1 -= mu; y2 -= mu; y3 -= mu;
    float q = (y0 * y0 + y1 * y1) + (y2 * y2 + y3 * y3);
    for (int o = 1; o < 64; o <<= 1) q += __shfl_xor(q, o);
    if ((t & 63) == 0) red[4 + (t >> 6)] = q;
    __syncthreads();
    const float var = (red[4] + red[5] + red[6] + red[7]) * (1.f / D);
    const float rs = rsqrtf(var + LN_EPS);
    float4 gv = ((const float4*)g)[t], bv = ((const float4*)bb)[t];
    float4 o = make_float4(y0 * rs * gv.x + bv.x, y1 * rs * gv.y + bv.y, y2 * rs * gv.z + bv.z, y3 * rs * gv.w + bv.w);
    ((float4*)(h + (size_t)r * D))[t] = o;
}

__global__ void __launch_bounds__(64) router(const float* __restrict__ h, const float* __restrict__ w_group, const float* __restrict__ b_group,
                                             const float* __restrict__ w_expert, const float* __restrict__ b_expert,
                                             int* __restrict__ cnt, int* __restrict__ list, float* __restrict__ tokgate) {
    const int t = blockIdx.x, lane = threadIdx.x;
    float acc[36];
#pragma unroll
    for (int j = 0; j < 36; ++j) acc[j] = 0.f;
    for (int k = lane; k < D; k += 64) {
        const float xv = h[(size_t)t * D + k];
#pragma unroll
        for (int j = 0; j < 4; ++j) acc[j] += xv * w_group[k * NG + j];
#pragma unroll
        for (int j = 0; j < 32; ++j) acc[4 + j] += xv * w_expert[k * NE + j];
    }
#pragma unroll
    for (int j = 0; j < 36; ++j) { float v = acc[j]; for (int o = 1; o < 64; o <<= 1) v += __shfl_xor(v, o); acc[j] = v; }
    if (lane == 0) {
        float gl[4]; int g = 0; float gm = -3.4e38f;
#pragma unroll
        for (int j = 0; j < 4; ++j) { gl[j] = acc[j] + b_group[j]; if (gl[j] > gm) { gm = gl[j]; g = j; } }
        float se = 0.f;
#pragma unroll
        for (int j = 0; j < 4; ++j) se += expf(gl[j] - gm);
        const float pg = 1.f / se;
        int i0 = -1, i1 = -1; float v0 = -3.4e38f, v1 = -3.4e38f;
#pragma unroll
        for (int j = 0; j < 32; ++j) {
            if ((j >> 3) == g) {
                const float v = acc[4 + j] + b_expert[j]; const int i = j & 7;
                if (v > v0) { v1 = v0; i1 = i0; v0 = v; i0 = i; }
                else if (v > v1) { v1 = v; i1 = i; }
            }
        }
        const float e1 = expf(v1 - v0);
        const float p0 = 1.f / (1.f + e1), p1 = e1 / (1.f + e1);
        const int ea = g * 8 + i0, eb = g * 8 + i1;
        tokgate[2 * t] = pg * p0; tokgate[2 * t + 1] = pg * p1;
        int pa = atomicAdd(&cnt[ea], 1); list[ea * CAP + pa] = 2 * t;
        int pb = atomicAdd(&cnt[eb], 1); list[eb * CAP + pb] = 2 * t + 1;
    }
}

__global__ void __launch_bounds__(256) combine_ln(float* __restrict__ h, const float* __restrict__ Cc, const float* __restrict__ g, const float* __restrict__ bb, float* __restrict__ out) {
    __shared__ float red[8];
    const int r = blockIdx.x, t = threadIdx.x;
    float4 hv = ((const float4*)(h + (size_t)r * D))[t];
    float4 c0 = ((const float4*)(Cc + (size_t)(2 * r) * D))[t], c1 = ((const float4*)(Cc + (size_t)(2 * r + 1) * D))[t];
    float y0 = ALPHA * hv.x + (c0.x + c1.x), y1 = ALPHA * hv.y + (c0.y + c1.y), y2 = ALPHA * hv.z + (c0.z + c1.z), y3 = ALPHA * hv.w + (c0.w + c1.w);
    float s = (y0 + y1) + (y2 + y3);
    for (int o = 1; o < 64; o <<= 1) s += __shfl_xor(s, o);
    if ((t & 63) == 0) red[t >> 6] = s;
    __syncthreads();
    const float mu = (red[0] + red[1] + red[2] + red[3]) * (1.f / D);
    y0 -= mu; y1 -= mu; y2 -= mu; y3 -= mu;
    float q = (y0 * y0 + y1 * y1) + (y2 * y2 + y3 * y3);
    for (int o = 1; o < 64; o <<= 1) q += __shfl_xor(q, o);
    if ((t & 63) == 0) red[4 + (t >> 6)] = q;
    __syncthreads();
    const float var = (red[4] + red[5] + red[6] + red[7]) * (1.f / D);
    const float rs = rsqrtf(var + LN_EPS);
    float4 gv = ((const float4*)g)[t], bv = ((const float4*)bb)[t];
    float4 o = make_float4(y0 * rs * gv.x + bv.x, y1 * rs * gv.y + bv.y, y2 * rs * gv.z + bv.z, y3 * rs * gv.w + bv.w);
    ((float4*)(h + (size_t)r * D))[t] = o;
    if (out && r < TREAL) ((float4*)(out + (size_t)r * D))[t] = o;
}

__device__ __forceinline__ long prev_row(long r, int d) {
    if (r < TREAL) { const int s = (int)(r % SEQ); if (s >= d) return r - d; return TREAL + NMETA + (s - d); }
    const int m = (int)(r - TREAL); return (m >= d) ? r - d : -1;
}
__global__ void sc_gate(float* __restrict__ bg, const float* __restrict__ cg, const float* __restrict__ v, const float* __restrict__ cw) {
    size_t i = (size_t)blockIdx.x * blockDim.x + threadIdx.x;
    for (; i < (size_t)NTOK * D; i += (size_t)gridDim.x * blockDim.x) {
        const long r = (long)(i / D); const int c = (int)(i % D);
        const long r1 = prev_row(r, 1), r2 = prev_row(r, 2);
        const float z0 = cg[i] * v[i];
        const float z1 = (r1 >= 0) ? cg[(size_t)r1 * D + c] * v[(size_t)r1 * D + c] : 0.f;
        const float z2 = (r2 >= 0) ? cg[(size_t)r2 * D + c] * v[(size_t)r2 * D + c] : 0.f;
        bg[i] = bg[i] * (cw[0 * D + c] * z2 + cw[1 * D + c] * z1 + cw[2 * D + c] * z0);
    }
}

static void moe(const float* h, const float* const* din, int layer, float* Hbuf, float* Cbuf, int* cnt, int* list, float* tokgate, hipStream_t st) {
    const float* w_group = (const float*)din[14] + (size_t)layer * D * NG; const float* b_group = (const float*)din[15] + layer * NG;
    const float* w_expert = (const float*)din[16] + (size_t)layer * D * NE; const float* b_expert = (const float*)din[17] + layer * NE;
    const float* w_gate = (const float*)din[18] + (size_t)layer * NE * D * DE; const float* w_up = (const float*)din[19] + (size_t)layer * NE * D * DE;
    const float* w_down = (const float*)din[20] + (size_t)layer * NE * DE * D;
    hipMemsetAsync(cnt, 0, NE * sizeof(int), st);
    router<<<NTOK, 64, 0, st>>>(h, w_group, b_group, w_expert, b_expert, cnt, list, tokgate);
    gemm<1><<<dim3(DE / 64, (NTOK + 63) / 64, NE), 256, 0, st>>>(h, D, w_gate, DE, w_up, Hbuf, DE, 0, DE, D, cnt, list, tokgate);
    gemm<2><<<dim3(D / 64, (NTOK + 63) / 64, NE), 256, 0, st>>>(Hbuf, DE, w_down, D, nullptr, Cbuf, D, 0, D, DE, cnt, list, tokgate);
}

static void forward(void* const* d_in, void* d_out, void* d_ws, hipStream_t st) {
    const float* const* din = (const float* const*)d_in;
    const size_t U = (size_t)R * D * sizeof(float);
    char* ws = (char*)d_ws;
    float* h = (float*)ws;
    float* b1 = (float*)(ws + U);
    float* b2 = (float*)(ws + 2 * U);
    float* b3 = (float*)(ws + 3 * U);
    char* tail = ws + 4 * U;
    int* cnt = (int*)tail; int* list = (int*)(tail + 4096); float* tokgate = (float*)(tail + 4096 + (size_t)NE * CAP * 4);
    const float* ln_g = din[21]; const float* ln_b = din[22];
    build_h<<<2048, 256, 0, st>>>(din[0], din[1], h);
    float* u = b1;
    gemm<0><<<dim3(2048 / 64, R / 64, 1), 256, 0, st>>>(h, D, din[2], 2048, nullptr, u, 2048, R, 2048, D, nullptr, nullptr, nullptr);
    gelu_left<<<4096, 256, 0, st>>>(u);
    lru_scan<<<NB * 16, 64, 0, st>>>(u, din[3], din[4], din[5], din[6], din[7], din[8], din[9]);
    gemm<0><<<dim3(D / 64, R / 64, 1), 256, 0, st>>>(u, 2048, din[10], D, nullptr, b3, D, R, D, D, nullptr, nullptr, nullptr);
    add_ln<<<R, 256, 0, st>>>(h, b3, D, ln_g + 0 * D, ln_b + 0 * D);
    moe(h, din, 0, b1, b2, cnt, list, tokgate, st);
    combine_ln<<<NTOK, 256, 0, st>>>(h, b2, ln_g + 1 * D, ln_b + 1 * D, nullptr);
    const float* wi1 = din[11];
    gemm<0><<<dim3(D / 64, R / 64, 1), 256, 0, st>>>(h, D, wi1 + 0, 3072, nullptr, b1, D, R, D, D, nullptr, nullptr, nullptr);
    gemm<0><<<dim3(D / 64, R / 64, 1), 256, 0, st>>>(h, D, wi1 + 1024, 3072, nullptr, b2, D, R, D, D, nullptr, nullptr, nullptr);
    gemm<0><<<dim3(D / 64, R / 64, 1), 256, 0, st>>>(h, D, wi1 + 2048, 3072, nullptr, b3, D, R, D, D, nullptr, nullptr, nullptr);
    sc_gate<<<4096, 256, 0, st>>>(b1, b2, b3, din[12]);
    gemm<0><<<dim3(D / 64, R / 64, 1), 256, 0, st>>>(b1, D, din[13], D, nullptr, b2, D, R, D, D, nullptr, nullptr, nullptr);
    add_ln<<<R, 256, 0, st>>>(h, b2, D, ln_g + 2 * D, ln_b + 2 * D);
    moe(h, din, 1, b1, b2, cnt, list, tokgate, st);
    combine_ln<<<NTOK, 256, 0, st>>>(h, b2, ln_g + 3 * D, ln_b + 3 * D, (float*)d_out);
}
}

extern "C" void kernel_launch(void* const* d_in, const int* in_sizes, int n_in, void* d_out, int out_size, void* d_ws, size_t ws_size, hipStream_t stream) {
    nv::forward(d_in, d_out, d_ws, stream);
}
```

```cpp
#define MK_N_LAUNCHES 1
#define MK_DEBUG_ORACLE 0
#include <hip/hip_runtime.h>
#include <cstdio>
#include <cstdint>

#ifndef MK_N_LAUNCHES
#define MK_N_LAUNCHES 1
#endif
#ifndef MK_DEBUG_ORACLE
#define MK_DEBUG_ORACLE 0
#endif

#define GAS __attribute__((address_space(1)))
#define LAS __attribute__((address_space(3)))
typedef unsigned short bf16_t;
typedef short bf16x8 __attribute__((ext_vector_type(8)));
typedef float f32x4 __attribute__((ext_vector_type(4)));
typedef float f32x2 __attribute__((ext_vector_type(2)));
typedef unsigned u32x4 __attribute__((ext_vector_type(4)));
typedef unsigned u32x2 __attribute__((ext_vector_type(2)));
typedef GAS unsigned gu32;

constexpr int D = 1024, NB = 4, SEQ = 8192, NMETA = 16;
constexpr int TREAL = NB * SEQ;
constexpr int NTOK = TREAL + NMETA;
constexpr int R = 33024;
constexpr int NE = 32, NG = 4, DE = 512;
constexpr int CAP = 32800;
constexpr int MAXMT = 288;
constexpr int HIDROWS = MAXMT * 256 + 256;
constexpr float ALPHA = 1.41421356237309515f;
constexpr float LN_EPS = 1e-5f;
constexpr int NPHASES = 15;

constexpr size_t MiB = 1u << 20;
constexpr size_t WS_CTL = 0, CTL_ZERO_BYTES = 1 * MiB;
constexpr size_t WS_LIST = 1 * MiB;
constexpr size_t WS_TOKGATE = 6 * MiB;
constexpr size_t WS_STATS = 6 * MiB + 512 * 1024;
constexpr size_t WS_SCANSUM = 11 * MiB;
constexpr size_t WS_WRF = 11 * MiB + 256 * 1024;
constexpr size_t WS_WAT = 11 * MiB + 512 * 1024;
constexpr size_t WS_WIN0 = 12 * MiB;
constexpr size_t WS_WOUT0 = 16 * MiB;
constexpr size_t WS_WIN1 = 18 * MiB;
constexpr size_t WS_WOUT1 = 24 * MiB;
constexpr size_t WS_GU = 26 * MiB;
constexpr size_t WS_DN = 90 * MiB;
constexpr size_t RB_BYTES = (size_t)R * D * 2;
constexpr size_t WS_RA = 122 * MiB;
constexpr size_t WS_RB = WS_RA + RB_BYTES;
constexpr size_t WS_RC = WS_RB + RB_BYTES;
constexpr size_t WS_RE = WS_RC + RB_BYTES;
constexpr size_t WS_END = WS_RE + 2 * RB_BYTES;
static_assert((size_t)HIDROWS * DE * 2 <= 2 * RB_BYTES, "HID fits RA+RB");
static_assert(WS_STATS + (size_t)R * 16 * 8 <= WS_SCANSUM, "stats");
constexpr size_t WS_DIGEST = 524 * MiB;
constexpr int CW_CNT = 64;
constexpr int CW_DBG = 256;
constexpr int CW_BAR = 4096;

constexpr int RING_BYTES = 131072;
constexpr int SMALL_OFF = RING_BYTES;
constexpr int MISC_OFF = RING_BYTES + 8192;
constexpr int LDS_BYTES = 147456;

#define RLX_AGENT __ATOMIC_RELAXED, __HIP_MEMORY_SCOPE_AGENT
#define LDS_WAIT() asm volatile("s_waitcnt lgkmcnt(0)" ::: "memory")
#define VM_WAIT() asm volatile("s_waitcnt vmcnt(0)" ::: "memory")

__device__ __forceinline__ unsigned cvt_pk_bf16(float lo, float hi) { unsigned r; asm volatile("v_cvt_pk_bf16_f32 %0, %1, %2" : "=v"(r) : "v"(lo), "v"(hi)); return r; }
__device__ __forceinline__ float bf_lo(unsigned w) { return __builtin_bit_cast(float, w << 16); }
__device__ __forceinline__ float bf_hi(unsigned w) { return __builtin_bit_cast(float, w & 0xffff0000u); }
__device__ __forceinline__ float bf1(unsigned short h) { return __builtin_bit_cast(float, ((unsigned)h) << 16); }
__device__ __forceinline__ void unpack8(const u32x4 w, float (&f)[8]) {
    f[0] = bf_lo(w.x); f[1] = bf_hi(w.x); f[2] = bf_lo(w.y); f[3] = bf_hi(w.y); f[4] = bf_lo(w.z); f[5] = bf_hi(w.z); f[6] = bf_lo(w.w); f[7] = bf_hi(w.w);
}
__device__ __forceinline__ u32x4 pack8(const float (&f)[8]) {
    u32x4 w; w.x = cvt_pk_bf16(f[0], f[1]); w.y = cvt_pk_bf16(f[2], f[3]); w.z = cvt_pk_bf16(f[4], f[5]); w.w = cvt_pk_bf16(f[6], f[7]); return w;
}
__device__ __forceinline__ float fast_sigmoid(float x) { return __builtin_amdgcn_rcpf(1.0f + __builtin_amdgcn_exp2f(-1.44269504089f * x)); }
__device__ __forceinline__ float gelu_tanh_f(float x) {
    const float z2 = 1.5957691216f * (x + 0.044715f * x * x * x);
    return x * fast_sigmoid(z2);
}
__device__ __forceinline__ float wave_sum(float v) {
#pragma unroll
    for (int o = 1; o < 64; o <<= 1) v += __shfl_xor(v, o);
    return v;
}
namespace pg8 {
constexpr int BM = 256, BK = 64, HALF = 128, HTB = HALF * BK * 2  , STAGE_BYTES = 8 * HTB, NXCD = 8, WGM = 8;
__host__ __device__ __forceinline__ int lds_byte(int r, int c) { const int st = (r >> 4) * 2 + (c >> 5), rr = r & 15, cc = c & 31, ob = rr * 64 + cc * 2; return st * 1024 + (ob ^ (((ob >> 9) & 1) << 5)); }
__host__ __device__ __forceinline__ void stage_rc(int b, int& R_, int& C_) { const int st = b / 1024, sb = b % 1024, swz = sb ^ (((sb >> 9) & 1) << 5); R_ = (st >> 1) * 16 + swz / 64; C_ = (st & 1) * 32 + (swz % 64) / 2; }
__host__ __device__ __forceinline__ int perm32(int rho) { const int n = rho >> 4, i = rho & 15; return 8 * (i >> 2) + 4 * n + (i & 3); }

struct Unit { int pm, pn, e, lt; };

struct DenseOrder {
    int nM, nN, nwg, G, c;
    __device__ __forceinline__ void init(int nM_, int nN_, int G_, int c_) { nM = nM_; nN = nN_; nwg = nM * nN; G = G_; c = c_; }
    __device__ __forceinline__ bool next(int i, Unit& u) const {
        const long L = (long)i * G + c; if (L >= nwg) return false;
        int wgid = (int)L; { const int q = nwg / NXCD, r = nwg % NXCD, xcd = wgid % NXCD, off = wgid / NXCD; wgid = (xcd < r ? xcd * (q + 1) : r * (q + 1) + (xcd - r) * q) + off; }
        const int nig = WGM * nN, gid = wgid / nig, fm = gid * WGM, gsz = (nM - fm) < WGM ? (nM - fm) : WGM;
        u.pm = fm + ((wgid % nig) % gsz); u.pn = (wgid % nig) / gsz; u.e = 0; u.lt = 0; return true;
    }
};

template <class P>
__device__ __forceinline__ void gemm_phase(LAS unsigned char* lds, const P& prob) {
    constexpr bool ALIGN_EPI = true;
    const int tid = threadIdx.x, wid = __builtin_amdgcn_readfirstlane(tid >> 6), lane = tid & 63, wr = wid >> 2, wc = wid & 3, fr = lane & 15, fq = lane >> 4;
    constexpr int K = P::K, nt = K / BK;
    int R0, C0; stage_rc(tid * 16, R0, C0);
    unsigned voffB[2];
#pragma unroll
    for (int i = 0; i < 2; ++i) { const int Rr = R0 + 64 * i; const int Rb = (Rr & ~31) + perm32(Rr & 31); voffB[i] = (unsigned)(Rb * K + C0) * 2u; }
    unsigned voffA[2][2];
    constexpr size_t kstep = (size_t)(BK * 2);
    constexpr size_t hstepB = (size_t)HALF * K * 2;
    const unsigned ldsw = (unsigned)wid * 1024u;
    const int aoff = lds_byte(wr * 64 + fr, fq * 8), boff = lds_byte(wc * 32 + fr, fq * 8);
#define PG8_SA(b, h) (((b) * 2 + (h)) * HTB)
#define PG8_SB(b, h) ((4 + (b) * 2 + (h)) * HTB)
#define PG8_STAGE(bufoff, gbase, voff) do { _Pragma("unroll") for (int _i = 0; _i < 2; ++_i) \
        __builtin_amdgcn_global_load_lds((const unsigned*)((const char*)(gbase) + (voff)[_i]), (LAS unsigned*)(lds + (bufoff) + ldsw + _i * 8192), 16, 0, 0); } while (0)
#define PG8_STAGE_A(bufoff, gbase, h) do { unsigned _va[2]; _Pragma("unroll") for (int _i = 0; _i < 2; ++_i) _va[_i] = P::GATHER ? voffA[h][_i] : (voffA[0][0] + (unsigned)(((h) * 128 + _i * 64) * K * 2)); PG8_STAGE(bufoff, gbase, _va); } while (0)
#define PG8_LDA(dst, b, h) do { _Pragma("unroll") for (int m = 0; m < 4; ++m) _Pragma("unroll") for (int k = 0; k < 2; ++k) dst[m][k] = *(const LAS bf16x8*)(lds + PG8_SA(b, h) + aoff + m * 2048 + k * 1024); } while (0)
#define PG8_LDB(dst, b, h) do { _Pragma("unroll") for (int n = 0; n < 2; ++n) _Pragma("unroll") for (int k = 0; k < 2; ++k) dst[n][k] = *(const LAS bf16x8*)(lds + PG8_SB(b, h) + boff + n * 2048 + k * 1024); } while (0)
#define PG8_MMA(ai, bj, At, Bt) do { __builtin_amdgcn_s_setprio(1); _Pragma("unroll") for (int m = 0; m < 4; ++m) _Pragma("unroll") for (int n = 0; n < 2; ++n) _Pragma("unroll") for (int k = 0; k < 2; ++k) \
        acc[ai][bj][m][n] = __builtin_amdgcn_mfma_f32_16x16x32_bf16(Bt[n][k], At[m][k], acc[ai][bj][m][n], 0, 0, 0); __builtin_amdgcn_s_setprio(0); } while (0)
#define PG8_WAIT_V(n) asm volatile("s_waitcnt vmcnt(" #n ")" ::: "memory")
#define PG8_WAIT_L(n) asm volatile("s_waitcnt lgkmcnt(" #n ")" ::: "memory")
#define PG8_BAR __builtin_amdgcn_s_barrier()
#define PG8_SCHED __builtin_amdgcn_sched_barrier(0)
    Unit cur, nxt; int ui = 0;
    if (!prob.next(0, cur)) return;
    f32x4 acc[2][2][4][2];
#pragma unroll
    for (int a = 0; a < 2; ++a)
#pragma unroll
        for (int b = 0; b < 2; ++b)
#pragma unroll
            for (int m = 0; m < 4; ++m)
#pragma unroll
                for (int n = 0; n < 2; ++n) acc[a][b][m][n] = (f32x4){0.f, 0.f, 0.f, 0.f};
    bf16x8 At[4][2], B0[2][2], B1[2][2];
    const char* const Ab = prob.Abase;
    const char* cB = prob.b_ptr(cur);
    prob.a_off(cur, R0, C0 * 2, voffA);
    PG8_STAGE(PG8_SB(0, 0), cB, voffB); PG8_STAGE(PG8_SB(0, 1), cB + hstepB, voffB); PG8_STAGE_A(PG8_SA(0, 0), Ab, 0); PG8_STAGE_A(PG8_SA(0, 1), Ab, 1);
    if (wr == 1) PG8_BAR;
    PG8_WAIT_V(2); PG8_BAR;
    PG8_STAGE(PG8_SB(1, 0), cB + kstep, voffB); PG8_STAGE_A(PG8_SA(1, 0), Ab + kstep, 0); PG8_STAGE(PG8_SB(1, 1), cB + hstepB + kstep, voffB);
    PG8_WAIT_V(6); PG8_BAR;
    for (;;) {
        const bool has_next = prob.next(ui + 1, nxt);
        const char* nB = has_next ? prob.b_ptr(nxt) : cB;
#pragma nounroll
        for (int t = 0; t < nt; t += 2) {
            const bool last = (t == nt - 2);
            const char* a1 = Ab + (size_t)(t + 1) * kstep;
            const char* a2 = last ? Ab : Ab + (size_t)(t + 2) * kstep; const char* b2 = last ? nB : cB + (size_t)(t + 2) * kstep;
            const char* a3 = a2 + kstep; const char* b3 = b2 + kstep;
            PG8_LDB(B0, 0, 0); PG8_LDB(B1, 0, 1); PG8_SCHED; PG8_LDA(At, 0, 0); PG8_STAGE_A(PG8_SA(1, 1), a1, 1);
            if (last && has_next) prob.a_off(nxt, R0, C0 * 2, voffA);
            PG8_WAIT_V(8); PG8_WAIT_L(0); PG8_BAR; PG8_MMA(0, 0, At, B0); PG8_MMA(0, 1, At, B1); PG8_BAR; PG8_SCHED;
            PG8_LDA(At, 0, 1); PG8_STAGE(PG8_SB(0, 0), b2, voffB); PG8_STAGE(PG8_SB(0, 1), b2 + hstepB, voffB); PG8_STAGE_A(PG8_SA(0, 0), a2, 0);
            PG8_WAIT_V(8); PG8_WAIT_L(0); PG8_BAR; PG8_MMA(1, 0, At, B0); PG8_MMA(1, 1, At, B1); PG8_BAR; PG8_SCHED;
            PG8_LDB(B0, 1, 0); PG8_LDB(B1, 1, 1); PG8_SCHED; PG8_LDA(At, 1, 0); PG8_STAGE_A(PG8_SA(0, 1), a2, 1);
            PG8_WAIT_V(8); PG8_WAIT_L(0); PG8_BAR; PG8_MMA(0, 0, At, B0); PG8_MMA(0, 1, At, B1); PG8_BAR; PG8_SCHED;
            PG8_LDA(At, 1, 1); PG8_STAGE(PG8_SB(1, 0), b3, voffB); PG8_STAGE(PG8_SB(1, 1), b3 + hstepB, voffB); PG8_STAGE_A(PG8_SA(1, 0), a3, 0);
            PG8_WAIT_V(8); PG8_WAIT_L(0); PG8_BAR; PG8_MMA(1, 0, At, B0); PG8_MMA(1, 1, At, B1); PG8_BAR; PG8_SCHED;
        }
        if constexpr (ALIGN_EPI) { if (wr == 0) PG8_BAR; }
        prob.epi(acc, cur, wr, wc, fr, fq);
        if (!has_next) break;
#pragma unroll
        for (int a = 0; a < 2; ++a)
#pragma unroll
            for (int b = 0; b < 2; ++b)
#pragma unroll
                for (int m = 0; m < 4; ++m)
#pragma unroll
                    for (int n = 0; n < 2; ++n) acc[a][b][m][n] = (f32x4){0.f, 0.f, 0.f, 0.f};
        cur = nxt; cB = nB; ++ui;
        if constexpr (ALIGN_EPI) { if (wr == 1) PG8_BAR; }
    }
    PG8_WAIT_V(0);
    PG8_BAR;
#undef PG8_SA
#undef PG8_SB
#undef PG8_STAGE
#undef PG8_STAGE_A
#undef PG8_LDA
#undef PG8_LDB
#undef PG8_MMA
#undef PG8_WAIT_V
#undef PG8_WAIT_L
#undef PG8_BAR
#undef PG8_SCHED
}
}
using pg8::Unit;
typedef f32x4 acc_t[2][2][4][2];

struct DenseA {
    static constexpr bool GATHER = false;
    const char* Abase; pg8::DenseOrder ord;
    __device__ __forceinline__ bool next(int i, Unit& u) const { return ord.next(i, u); }
    template <int K> __device__ __forceinline__ void a_off_k(const Unit& u, int R0, int C2, unsigned (&vo)[2][2]) const {
#pragma unroll
        for (int h = 0; h < 2; ++h)
#pragma unroll
            for (int i = 0; i < 2; ++i) vo[h][i] = (unsigned)((u.pm * 256 + h * 128 + R0 + 64 * i) * K * 2 + C2);
    }
};

struct ProbIn0 : DenseA {
    static constexpr int K = 1024;
    const char* Bt; bf16_t* ybr; bf16_t* xraw;
    __device__ __forceinline__ void a_off(const Unit& u, int R0, int C2, unsigned (&vo)[2][2]) const { a_off_k<K>(u, R0, C2, vo); }
    __device__ __forceinline__ const char* b_ptr(const Unit& u) const { return Bt + (size_t)u.pn * 256 * K * 2; }
    __device__ __forceinline__ void epi(const acc_t& acc, const Unit& u, int wr, int wc, int fr, int fq) const {
        const bool left = u.pn < 4;
        bf16_t* base = left ? ybr : xraw;
        const int col0 = (u.pn & 3) * 256 + wc * 32 + 8 * fq, row0 = u.pm * 256 + wr * 64 + fr;
#pragma unroll
        for (int ai = 0; ai < 2; ++ai)
#pragma unroll
            for (int m = 0; m < 4; ++m) { bf16_t* rowp = base + (size_t)(row0 + ai * 128 + m * 16) * D + col0;
#pragma unroll
                for (int bj = 0; bj < 2; ++bj) { f32x4 v0 = acc[ai][bj][m][0], v1 = acc[ai][bj][m][1];
                    if (left) {
#pragma unroll
                        for (int j = 0; j < 4; ++j) { v0[j] = gelu_tanh_f(v0[j]); v1[j] = gelu_tanh_f(v1[j]); } }
                    u32x4 w; w.x = cvt_pk_bf16(v0[0], v0[1]); w.y = cvt_pk_bf16(v0[2], v0[3]); w.z = cvt_pk_bf16(v1[0], v1[1]); w.w = cvt_pk_bf16(v1[2], v1[3]);
                    *(u32x4*)(rowp + bj * 128) = w; } }
    }
};

template <bool RES_F32> struct ProbOut : DenseA {
    static constexpr int K = 1024;
    const char* Bt; bf16_t* y1; f32x2* stats;
    const float* x; const float* meta;
    const bf16_t* hres;
    __device__ __forceinline__ void a_off(const Unit& u, int R0, int C2, unsigned (&vo)[2][2]) const { a_off_k<K>(u, R0, C2, vo); }
    __device__ __forceinline__ const char* b_ptr(const Unit& u) const { return Bt + (size_t)u.pn * 256 * K * 2; }
    __device__ __forceinline__ void epi(const acc_t& acc, const Unit& u, int wr, int wc, int fr, int fq) const {
        const int col0 = u.pn * 256 + wc * 32 + 8 * fq, row0 = u.pm * 256 + wr * 64 + fr;
#pragma unroll
        for (int ai = 0; ai < 2; ++ai)
#pragma unroll
            for (int m = 0; m < 4; ++m) {
                const int row = row0 + ai * 128 + m * 16;
                float s1 = 0.f, s2 = 0.f;
                bf16_t* rowp = y1 + (size_t)row * D + col0;
                float al = ALPHA; const float* rp = nullptr; const bf16_t* hp = nullptr;
                if (RES_F32) { const int rc = row < NTOK ? row : NTOK - 1; rp = (rc < TREAL) ? (x + (size_t)rc * D) : (meta + (size_t)(rc - TREAL) * D); rp += col0; al = row < NTOK ? ALPHA : 0.f; }
                else hp = hres + (size_t)row * D + col0;
#pragma unroll
                for (int bj = 0; bj < 2; ++bj) {
                    float r8[8];
                    if (RES_F32) { const f32x4 a = *(const f32x4*)(rp + bj * 128), b = *(const f32x4*)(rp + bj * 128 + 4);
                        r8[0] = a[0]; r8[1] = a[1]; r8[2] = a[2]; r8[3] = a[3]; r8[4] = b[0]; r8[5] = b[1]; r8[6] = b[2]; r8[7] = b[3]; }
                    else { const u32x4 hw = *(const u32x4*)(hp + bj * 128); unpack8(hw, r8); }
                    float v[8];
#pragma unroll
                    for (int j = 0; j < 4; ++j) { v[j] = acc[ai][bj][m][0][j] + al * r8[j]; v[4 + j] = acc[ai][bj][m][1][j] + al * r8[4 + j]; }
#pragma unroll
                    for (int j = 0; j < 8; ++j) { s1 += v[j]; s2 += v[j] * v[j]; }
                    *(u32x4*)(rowp + bj * 128) = pack8(v);
                }
                s1 += __shfl_xor(s1, 16); s1 += __shfl_xor(s1, 32); s2 += __shfl_xor(s2, 16); s2 += __shfl_xor(s2, 32);
                if (fq == 0) stats[(size_t)row * 16 + u.pn * 4 + wc] = (f32x2){s1, s2};
            }
    }
};

struct ProbIn1 : DenseA {
    static constexpr int K = 1024;
    const char* Bt; bf16_t* bg; bf16_t* z;
    __device__ __forceinline__ void a_off(const Unit& u, int R0, int C2, unsigned (&vo)[2][2]) const { a_off_k<K>(u, R0, C2, vo); }
    __device__ __forceinline__ const char* b_ptr(const Unit& u) const { return Bt + (size_t)u.pn * 256 * K * 2; }
    __device__ __forceinline__ void epi(const acc_t& acc, const Unit& u, int wr, int wc, int fr, int fq) const {
        const int row0 = u.pm * 256 + wr * 64 + fr;
        if (u.pn < 4) {
            const int col0 = u.pn * 256 + wc * 32 + 8 * fq;
#pragma unroll
            for (int ai = 0; ai < 2; ++ai)
#pragma unroll
                for (int m = 0; m < 4; ++m) { bf16_t* rowp = bg + (size_t)(row0 + ai * 128 + m * 16) * D + col0;
#pragma unroll
                    for (int bj = 0; bj < 2; ++bj) { const f32x4 v0 = acc[ai][bj][m][0], v1 = acc[ai][bj][m][1];
                        u32x4 w; w.x = cvt_pk_bf16(v0[0], v0[1]); w.y = cvt_pk_bf16(v0[2], v0[3]); w.z = cvt_pk_bf16(v1[0], v1[1]); w.w = cvt_pk_bf16(v1[2], v1[3]);
                        *(u32x4*)(rowp + bj * 128) = w; } }
        } else {
            const int col0 = (u.pn - 4) * 128 + wc * 32 + 8 * fq;
#pragma unroll
            for (int ai = 0; ai < 2; ++ai)
#pragma unroll
                for (int m = 0; m < 4; ++m) { bf16_t* rowp = z + (size_t)(row0 + ai * 128 + m * 16) * D + col0;
                    const f32x4 v0 = acc[ai][0][m][0] * acc[ai][1][m][0], v1 = acc[ai][0][m][1] * acc[ai][1][m][1];
                    u32x4 w; w.x = cvt_pk_bf16(v0[0], v0[1]); w.y = cvt_pk_bf16(v0[2], v0[3]); w.z = cvt_pk_bf16(v1[0], v1[1]); w.w = cvt_pk_bf16(v1[2], v1[3]);
                    *(u32x4*)rowp = w; }
        }
    }
};

struct MoeOrder {
    const LAS int* tbl; int c, total;
    __device__ __forceinline__ bool next(int i, Unit& u) const {
        const int L = (i * 8 + (c & 7)) * 32 + (c >> 3);
        if (L >= total) return false;
        const int mt = L >> 2; u.pn = L & 3; u.pm = mt;
        int e = 0;
#pragma unroll 1
        for (int j = 1; j < NE; ++j) if (tbl[32 + j] <= mt) e = j;
        u.e = e; u.lt = mt - tbl[32 + e];
        return true;
    }
};

struct ProbUp {
    static constexpr int K = 1024; static constexpr bool GATHER = true;
    const char* Abase; MoeOrder ord; const char* gu; const int* list; bf16_t* hid;
    __device__ __forceinline__ bool next(int i, Unit& u) const { return ord.next(i, u); }
    __device__ __forceinline__ void a_off(const Unit& u, int R0, int C2, unsigned (&vo)[2][2]) const {
        const int cnt = ord.tbl[u.e];
#pragma unroll
        for (int h = 0; h < 2; ++h)
#pragma unroll
            for (int i = 0; i < 2; ++i) { const int rank = u.lt * 256 + h * 128 + R0 + 64 * i;
                int tok = R - 1;
                if (rank < cnt) tok = list[u.e * CAP + rank] >> 1;
                vo[h][i] = (unsigned)(tok * (K * 2) + C2); }
    }
    __device__ __forceinline__ const char* b_ptr(const Unit& u) const { return gu + ((size_t)u.e * 1024 + (size_t)u.pn * 256) * K * 2; }
    __device__ __forceinline__ void epi(const acc_t& acc, const Unit& u, int wr, int wc, int fr, int fq) const {
        const int col0 = u.pn * 128 + wc * 32 + 8 * fq, row0 = u.pm * 256 + wr * 64 + fr;
#pragma unroll
        for (int ai = 0; ai < 2; ++ai)
#pragma unroll
            for (int m = 0; m < 4; ++m) { bf16_t* rowp = hid + (size_t)(row0 + ai * 128 + m * 16) * DE + col0;
                float v[8];
#pragma unroll
                for (int j = 0; j < 4; ++j) { const float g0 = acc[ai][0][m][0][j], g1 = acc[ai][0][m][1][j];
                    v[j] = g0 * fast_sigmoid(g0) * acc[ai][1][m][0][j]; v[4 + j] = g1 * fast_sigmoid(g1) * acc[ai][1][m][1][j]; }
                *(u32x4*)rowp = pack8(v); }
    }
};

struct ProbDown {
    static constexpr int K = 512; static constexpr bool GATHER = false;
    const char* Abase; MoeOrder ord; const char* dn; const int* list; const float* tokgate; bf16_t* cbuf;
    __device__ __forceinline__ bool next(int i, Unit& u) const { return ord.next(i, u); }
    __device__ __forceinline__ void a_off(const Unit& u, int R0, int C2, unsigned (&vo)[2][2]) const {
#pragma unroll
        for (int h = 0; h < 2; ++h)
#pragma unroll
            for (int i = 0; i < 2; ++i) vo[h][i] = (unsigned)((u.pm * 256 + h * 128 + R0 + 64 * i) * K * 2 + C2);
    }
    __device__ __forceinline__ const char* b_ptr(const Unit& u) const { return dn + ((size_t)u.e * 1024 + (size_t)u.pn * 256) * K * 2; }
    __device__ __forceinline__ void epi(const acc_t& acc, const Unit& u, int wr, int wc, int fr, int fq) const {
        const int cnt = ord.tbl[u.e];
        const int col0 = u.pn * 256 + wc * 32 + 8 * fq, rr0 = wr * 64 + fr;
#pragma unroll
        for (int ai = 0; ai < 2; ++ai)
#pragma unroll
            for (int m = 0; m < 4; ++m) {
                const int rank = u.lt * 256 + rr0 + ai * 128 + m * 16;
                const bool ok = rank < cnt;
                const int li = list[u.e * CAP + (ok ? rank : 0)];
                const float gt = tokgate[li];
                bf16_t* rowp = cbuf + (size_t)li * D + col0;
#pragma unroll
                for (int bj = 0; bj < 2; ++bj) { const f32x4 v0 = acc[ai][bj][m][0] * gt, v1 = acc[ai][bj][m][1] * gt;
                    u32x4 w; w.x = cvt_pk_bf16(v0[0], v0[1]); w.y = cvt_pk_bf16(v0[2], v0[3]); w.z = cvt_pk_bf16(v1[0], v1[1]); w.w = cvt_pk_bf16(v1[2], v1[3]);
                    if (ok) *(u32x4*)(rowp + bj * 128) = w; } }
    }
};
struct Args { const float* in[23]; float* out; unsigned char* ws; int ph_lo, ph_hi; };
struct Frame {
    LAS unsigned char* lds;
    int tid, lane, wave, bid, G;
    unsigned char* ws;
};
#define WSP(T, off) ((T*)(F.ws + (off)))

__device__ __forceinline__ void transpose_item(const float* __restrict__ W, int ldw, int k0, int n0, bf16_t* __restrict__ WT, int ldk, int drow0, LAS float* scr, int lane) {
#pragma unroll 8
    for (int i = 0; i < 32; ++i) { const int kk = 2 * i + (lane >> 5); scr[kk * 33 + (lane & 31)] = W[(size_t)(k0 + kk) * ldw + n0 + (lane & 31)]; }
    LDS_WAIT(); asm volatile("" ::: "memory");
    const int c = lane & 7;
#pragma unroll
    for (int j = 0; j < 4; ++j) { const int n = (lane >> 3) + 8 * j; const LAS float* s = scr + (8 * c) * 33 + n;
        u32x4 o; o.x = cvt_pk_bf16(s[0 * 33], s[1 * 33]); o.y = cvt_pk_bf16(s[2 * 33], s[3 * 33]); o.z = cvt_pk_bf16(s[4 * 33], s[5 * 33]); o.w = cvt_pk_bf16(s[6 * 33], s[7 * 33]);
        *(u32x4*)(WT + (size_t)(drow0 + n) * ldk + k0 + 8 * c) = o; }
    LDS_WAIT(); asm volatile("" ::: "memory");
}
template <int MAP> __device__ __forceinline__ void transpose_dense_item(const float* W, int K, int N, bf16_t* WT, int item, LAS float* scr, int lane) {
    const int nblk = N / 32, kb = item / nblk, nb = item % nblk, n0 = nb * 32;
    int drow = n0;
    if (MAP == 1 && n0 >= 1024) { const int s = (n0 >= 2048) ? 1 : 0, j = n0 - 1024 - 1024 * s; drow = 1024 + 256 * (j >> 7) + 128 * s + (j & 127); }
    transpose_item(W, N, kb * 64, n0, WT, K, drow, scr, lane);
}
__device__ __forceinline__ void transpose_moe_item(const Frame& F, const Args& A, int layer, int item, LAS float* scr, int lane) {
    const int e = item / 768, r = item % 768, kind = r >> 8, q = r & 255;
    bf16_t* gu = WSP(bf16_t, WS_GU) + (size_t)e * 1024 * 1024; bf16_t* dn = WSP(bf16_t, WS_DN) + (size_t)e * 1024 * 512;
    if (kind < 2) {
        const float* W = (kind ? A.in[19] : A.in[18]) + ((size_t)layer * NE + e) * D * DE;
        const int kb = q >> 4, nb = q & 15, n0 = nb * 32;
        transpose_item(W, DE, kb * 64, n0, gu, D, 256 * (n0 >> 7) + 128 * kind + (n0 & 127), scr, lane);
    } else {
        const float* W = A.in[20] + ((size_t)layer * NE + e) * DE * D;
        const int kb = q >> 5, nb = q & 31, n0 = nb * 32;
        transpose_item(W, D, kb * 64, n0, dn, DE, n0, scr, lane);
    }
}
__device__ __forceinline__ void p0_prologue(const Frame& F, const Args& A) {
    LAS float* scr = (LAS float*)(F.lds + F.wave * 8448);
    const int gw = F.bid * 8 + F.wave, NGW = F.G * 8;
    const int gt = F.bid * 512 + F.tid, NT = F.G * 512;
    bf16_t* A0 = WSP(bf16_t, WS_RA);
    for (int p = gt; p < R * 128; p += NT) {
        const int r = p >> 7, c8 = (p & 127) * 8;
        u32x4 o = (u32x4){0u, 0u, 0u, 0u};
        if (r < NTOK) { const float* src = (r < TREAL) ? (A.in[0] + (size_t)r * D) : (A.in[1] + (size_t)(r - TREAL) * D);
            const f32x4 a = *(const f32x4*)(src + c8), b = *(const f32x4*)(src + c8 + 4);
            o.x = cvt_pk_bf16(a[0], a[1]); o.y = cvt_pk_bf16(a[2], a[3]); o.z = cvt_pk_bf16(b[0], b[1]); o.w = cvt_pk_bf16(b[2], b[3]); }
        *(u32x4*)(A0 + (size_t)r * D + c8) = o;
    }
    constexpr int I0 = 16 * 64, I1 = 16 * 32, I2 = 16 * 96, I3 = 16 * 32, IM = NE * 768;
    for (int it = gw; it < I0 + I1 + I2 + I3 + IM; it += NGW) {
        int r = it;
        if (r < I0) { transpose_dense_item<0>(A.in[2], D, 2048, WSP(bf16_t, WS_WIN0), r, scr, F.lane); continue; } r -= I0;
        if (r < I1) { transpose_dense_item<0>(A.in[10], D, D, WSP(bf16_t, WS_WOUT0), r, scr, F.lane); continue; } r -= I1;
        if (r < I2) { transpose_dense_item<1>(A.in[11], D, 3072, WSP(bf16_t, WS_WIN1), r, scr, F.lane); continue; } r -= I2;
        if (r < I3) { transpose_dense_item<0>(A.in[13], D, D, WSP(bf16_t, WS_WOUT1), r, scr, F.lane); continue; } r -= I3;
        transpose_moe_item(F, A, 0, r, scr, F.lane);
    }
    bf16_t* wat = WSP(bf16_t, WS_WAT);
    for (int p = gt; p < 2 * 65536; p += NT) {
        const int which = p >> 16, q = p & 65535, hd = q >> 12, e = (q >> 6) & 63, d = q & 63;
        const float v = (which ? A.in[7] : A.in[5])[(hd * 64 + d) * 64 + e];
        wat[p] = (bf16_t)(cvt_pk_bf16(v, 0.f) & 0xffffu);
    }
    bf16_t* wrf = WSP(bf16_t, WS_WRF);
    for (int p = gt; p < 2 * 32 * 3 * 64 * 8; p += NT) {
        const int jj = p & 7, ln = (p >> 3) & 63, sb = (p >> 9) % 96, layer = p / (96 * 512), s = sb / 3, blk = sb % 3;
        const int n = blk * 16 + (ln & 15), k = 32 * s + 8 * (ln >> 4) + jj;
        float v = 0.f;
        if (n < 4) v = A.in[14][((size_t)layer * D + k) * NG + n];
        else if (n >= 16) v = A.in[16][((size_t)layer * D + k) * NE + (n - 16)];
        wrf[p] = (bf16_t)(cvt_pk_bf16(v, 0.f) & 0xffffu);
    }
}

constexpr int P2_XR = 0, P2_YB = 16896, P2_XC = 33280, P2_AS = 49664, P2_BS = 82432, P2_SUB = 115200  , P2_HST = 119296  , P2_CW = 119808  ;
template <bool APPLY>
__device__ __forceinline__ void p2_lru(const Frame& F, const Args& A) {
    const bf16_t* xraw = WSP(bf16_t, WS_RC); const bf16_t* ybr = WSP(bf16_t, WS_RB); bf16_t* gout = WSP(bf16_t, WS_RA);
    float* scansum = WSP(float, WS_SCANSUM);
    LAS unsigned char* L = F.lds;
    LAS float* AS = (LAS float*)(L + P2_AS); LAS float* BS = (LAS float*)(L + P2_BS);
    LAS float* subA = (LAS float*)(L + P2_SUB); LAS float* subB = subA + 512;
    LAS float* hst = (LAS float*)(L + P2_HST); LAS float* pst = hst + 64;
    LAS float* cwl = (LAS float*)(L + P2_CW);
    const LAS bf16_t* XR = (const LAS bf16_t*)(L + P2_XR);
    LAS bf16_t* YB = (LAS bf16_t*)(L + P2_YB);
    const int tid = F.tid, lane = F.lane, w = F.wave;
    for (int u = F.bid; u < 256; u += F.G) {
        const int b = u >> 6, hd = (u >> 2) & 15, sg = u & 3;
        __syncthreads();
        if (tid < 64) { hst[tid] = 0.f; pst[tid] = 1.f; }
        if (tid < 320) { const int k = tid >> 6, c = tid & 63; cwl[tid] = (k < 4) ? A.in[3][k * D + hd * 64 + c] : A.in[4][hd * 64 + c]; }
        float cba[4], cbi[4], csp[4];
#pragma unroll
        for (int n = 0; n < 4; ++n) { const int c = hd * 64 + 16 * n + (lane & 15); cba[n] = A.in[6][c]; cbi[n] = A.in[8][c];
            const float nl = -A.in[9][c]; csp[n] = 8.0f * ((nl > 20.f) ? nl : log1pf(expf(nl))); }
        const int cs = lane;
        float h0 = 0.f;
        if (APPLY) {
#pragma unroll 1
            for (int s2 = 0; s2 < sg; ++s2) { const float* sp = scansum + ((size_t)(u - sg + s2) * 64 + cs) * 2; h0 = sp[0] * h0 + sp[1]; }
        }
        __syncthreads();
        if (APPLY && tid < 64) hst[tid] = h0;
        const float w0 = cwl[0 * 64 + cs], w1 = cwl[1 * 64 + cs], w2 = cwl[2 * 64 + cs], w3 = cwl[3 * 64 + cs], wb = cwl[4 * 64 + cs];
        const int nch = (sg == 0) ? 17 : 16;
#pragma unroll 1
        for (int ch = 0; ch < nch; ++ch) {
            const bool metac = (sg == 0 && ch == 0);
            const int creal = (sg == 0) ? ch - 1 : ch;
            const int P0 = metac ? 0 : NMETA + sg * 2048 + creal * 128;
            const int nvalid = metac ? NMETA : 128;
            __syncthreads();
            for (int p = tid; p < 131 * 8; p += 512) {
                const int i = p >> 3, pc = p & 7, pos = P0 - 3 + i;
                u32x4 v = (u32x4){0u, 0u, 0u, 0u};
                if (pos >= 0 && i < nvalid + 3) { const size_t row = (pos < NMETA) ? (size_t)(TREAL + pos) : ((size_t)b * SEQ + (pos - NMETA));
                    v = *(const u32x4*)(xraw + row * D + hd * 64 + pc * 8); }
                *(LAS u32x4*)(L + P2_XR + i * 128 + pc * 16) = v;
            }
            if (APPLY) for (int p = tid; p < 128 * 8; p += 512) {
                const int i = p >> 3, pc = p & 7, pos = P0 + i;
                u32x4 v = (u32x4){0u, 0u, 0u, 0u};
                if (i < nvalid) { const size_t row = (pos < NMETA) ? (size_t)(TREAL + pos) : ((size_t)b * SEQ + (pos - NMETA));
                    v = *(const u32x4*)(ybr + row * D + hd * 64 + pc * 8); }
                *(LAS u32x4*)(L + P2_YB + i * 128 + pc * 16) = v;
            }
            __syncthreads();
            for (int p = tid; p < 128 * 8; p += 512) {
                const int t = p >> 3, pc = p & 7;
                float xa[8], xb[8], xc_[8], xd[8], o[8];
                unpack8(*(const LAS u32x4*)(L + P2_XR + (t + 0) * 128 + pc * 16), xa);
                unpack8(*(const LAS u32x4*)(L + P2_XR + (t + 1) * 128 + pc * 16), xb);
                unpack8(*(const LAS u32x4*)(L + P2_XR + (t + 2) * 128 + pc * 16), xc_);
                unpack8(*(const LAS u32x4*)(L + P2_XR + (t + 3) * 128 + pc * 16), xd);
#pragma unroll
                for (int j = 0; j < 8; ++j) { const int c = pc * 8 + j; o[j] = cwl[c] * xa[j] + cwl[64 + c] * xb[j] + cwl[128 + c] * xc_[j] + cwl[192 + c] * xd[j] + cwl[256 + c]; }
                *(LAS u32x4*)(L + P2_XC + t * 128 + ((pc ^ ((t >> 1) & 7)) << 4)) = pack8(o);
            }
            __syncthreads();
            {
                const int fr = lane & 15, fq = lane >> 4, row = 16 * w + fr;
                const bf16_t* wat = WSP(bf16_t, WS_WAT) + (size_t)hd * 4096 + fr * 64 + 8 * fq;
                asm volatile("" : "+v"(wat));
                bf16x8 af[2];
#pragma unroll
                for (int s = 0; s < 2; ++s) af[s] = *(const LAS bf16x8*)(L + P2_XC + row * 128 + (((4 * s + fq) ^ ((row >> 1) & 7)) << 4));
#pragma unroll
                for (int n = 0; n < 4; ++n) {
                    f32x4 ca = (f32x4){0.f, 0.f, 0.f, 0.f}, ci = ca;
#pragma unroll
                    for (int s = 0; s < 2; ++s) { const bf16x8 fa = *(const bf16x8*)(wat + n * 1024 + 32 * s), fi = *(const bf16x8*)(wat + 65536 + n * 1024 + 32 * s);
                        ca = __builtin_amdgcn_mfma_f32_16x16x32_bf16(af[s], fa, ca, 0, 0, 0); ci = __builtin_amdgcn_mfma_f32_16x16x32_bf16(af[s], fi, ci, 0, 0, 0); }
#pragma unroll
                    for (int j = 0; j < 4; ++j) {
                        const int t = 16 * w + 4 * fq + j, c = 16 * n + fr;
                        const float r = fast_sigmoid(ca[j] + cba[n]), gi = fast_sigmoid(ci[j] + cbi[n]);
                        const float la = -csp[n] * r;
                        float a = __builtin_amdgcn_exp2f(1.44269504089f * la);
                        const float x2 = 2.f * la;
                        const float om = (x2 > -0.06f) ? (-x2 * (1.f + x2 * (0.5f + x2 * (0.16666667f + x2 * 0.041666667f)))) : (1.f - a * a);
                        float bm = __builtin_sqrtf(om) * gi;
                        if (t >= nvalid) { a = 1.f; bm = 0.f; }
                        AS[t * 64 + c] = a; BS[t * 64 + c] = bm;
                    }
                }
            }
            __syncthreads();
            float av[16], bv[16];
            {
                float x3 = bf1(XR[(16 * w + 0) * 64 + cs]), x2 = bf1(XR[(16 * w + 1) * 64 + cs]), x1 = bf1(XR[(16 * w + 2) * 64 + cs]);
                float Pp = 1.f, Hl = 0.f;
#pragma unroll
                for (int j = 0; j < 16; ++j) { const int t = 16 * w + j;
                    const float x0 = bf1(XR[(t + 3) * 64 + cs]);
                    const float xcv = w0 * x3 + w1 * x2 + w2 * x1 + w3 * x0 + wb;
                    x3 = x2; x2 = x1; x1 = x0;
                    av[j] = AS[t * 64 + cs]; bv[j] = BS[t * 64 + cs] * xcv;
                    Hl = av[j] * Hl + bv[j]; Pp *= av[j]; }
                subA[w * 64 + cs] = Pp; subB[w * 64 + cs] = Hl;
            }
            __syncthreads();
            float hin = hst[cs], pin = pst[cs];
#pragma unroll 1
            for (int s2 = 0; s2 < w; ++s2) { hin = subA[s2 * 64 + cs] * hin + subB[s2 * 64 + cs]; pin *= subA[s2 * 64 + cs]; }
            __syncthreads();
            if (w == 7) { hst[cs] = subA[7 * 64 + cs] * hin + subB[7 * 64 + cs]; pst[cs] = pin * subA[7 * 64 + cs]; }
            if (APPLY) {
                float h = hin;
#pragma unroll
                for (int j = 0; j < 16; ++j) { const int t = 16 * w + j; h = av[j] * h + bv[j];
                    const float g = h * bf1(YB[t * 64 + cs]);
                    YB[t * 64 + cs] = (bf16_t)(cvt_pk_bf16(g, 0.f) & 0xffffu); }
                __syncthreads();
                if (!metac || b == 0) for (int p = tid; p < 128 * 8; p += 512) {
                    const int i = p >> 3, pc = p & 7, pos = P0 + i;
                    if (i < nvalid) { const size_t row = (pos < NMETA) ? (size_t)(TREAL + pos) : ((size_t)b * SEQ + (pos - NMETA));
                        *(u32x4*)(gout + row * D + hd * 64 + pc * 8) = *(const LAS u32x4*)(L + P2_YB + i * 128 + pc * 16); }
                }
            }
        }
        __syncthreads();
        if (!APPLY && tid < 64) { float* sp = scansum + ((size_t)u * 64 + tid) * 2; sp[0] = pst[tid]; sp[1] = hst[tid]; }
    }
}
constexpr int P4_WRF = 0, P4_LNG = 98304, P4_LNB = 102400, P4_LG = 106496  , P4_HIST = SMALL_OFF, P4_BASE = SMALL_OFF + 256;
__device__ __forceinline__ void p4_ln_route(const Frame& F, const Args& A, int layer, const bf16_t* y1, bf16_t* h1) {
    LAS unsigned char* L = F.lds;
    const int tid = F.tid, lane = F.lane, w = F.wave;
    const f32x2* stats = WSP(const f32x2, WS_STATS);
    int* list = WSP(int, WS_LIST); float* tokgate = WSP(float, WS_TOKGATE);
    unsigned* cnt = WSP(unsigned, WS_CTL) + CW_CNT + 64 * layer;
    const float* lng = A.in[21] + (size_t)(layer * 2 + 0) * D; const float* lnb = A.in[22] + (size_t)(layer * 2 + 0) * D;
    const float* bgrp = A.in[15] + layer * NG; const float* bexp = A.in[17] + layer * NE;
    __syncthreads();
    { const u32x4* src = (const u32x4*)(WSP(bf16_t, WS_WRF) + (size_t)layer * 49152);
      for (int p = tid; p < 6144; p += 512) *(LAS u32x4*)(L + P4_WRF + p * 16) = src[p];
      for (int p = tid; p < 256; p += 512) { *(LAS f32x4*)(L + P4_LNG + p * 16) = ((const f32x4*)lng)[p]; *(LAS f32x4*)(L + P4_LNB + p * 16) = ((const f32x4*)lnb)[p]; } }
    for (int p = F.bid * 512 + tid; p < (R - NTOK) * 128; p += F.G * 512) *(u32x4*)(h1 + (size_t)(NTOK + (p >> 7)) * D + (p & 127) * 8) = (u32x4){0u, 0u, 0u, 0u};
    LAS int* hist = (LAS int*)(L + P4_HIST); LAS int* basep = (LAS int*)(L + P4_BASE);
    LAS float* LG = (LAS float*)(L + P4_LG + w * 2048);
    const int gw = F.bid * 8 + w, NGW = F.G * 8;
    constexpr int NGROUPS = NTOK / 16;
    const int niter = (NGROUPS + NGW - 1) / NGW;
#pragma unroll 1
    for (int it = 0; it < niter; ++it) {
        const int grp = it * NGW + gw;
        const bool active = grp < NGROUPS;
        __syncthreads();
        if (tid < 32) hist[tid] = 0;
        __syncthreads();
        int e0 = 0, e1 = 0, r0 = 0, r1 = 0; float g0 = 0.f, g1 = 0.f;
        const int fr = lane & 15, q = lane >> 4;
        const int tok = grp * 16 + fr;
        if (active) {
            const f32x4 pa = *(const f32x4*)(stats + (size_t)tok * 16 + 4 * q), pb = *(const f32x4*)(stats + (size_t)tok * 16 + 4 * q + 2);
            float s1 = (pa[0] + pa[2]) + (pb[0] + pb[2]), s2 = (pa[1] + pa[3]) + (pb[1] + pb[3]);
            s1 += __shfl_xor(s1, 16); s1 += __shfl_xor(s1, 32); s2 += __shfl_xor(s2, 16); s2 += __shfl_xor(s2, 32);
            const float mu = s1 * (1.f / D), var = fmaxf(s2 * (1.f / D) - mu * mu, 0.f), rstd = __builtin_amdgcn_rsqf(var + LN_EPS);
            f32x4 acc[3];
#pragma unroll
            for (int k = 0; k < 3; ++k) acc[k] = (f32x4){0.f, 0.f, 0.f, 0.f};
            const bf16_t* yrow = y1 + (size_t)tok * D + 8 * q; bf16_t* hrow = h1 + (size_t)tok * D + 8 * q;
#pragma unroll 4
            for (int s = 0; s < 32; ++s) {
                float y[8], g[8], bb[8], h[8];
                unpack8(*(const u32x4*)(yrow + 32 * s), y);
                const int k0 = 32 * s + 8 * q;
                { const f32x4 ga = *(const LAS f32x4*)(L + P4_LNG + k0 * 4), gb = *(const LAS f32x4*)(L + P4_LNG + k0 * 4 + 16);
                  const f32x4 ba = *(const LAS f32x4*)(L + P4_LNB + k0 * 4), bc = *(const LAS f32x4*)(L + P4_LNB + k0 * 4 + 16);
#pragma unroll
                  for (int j = 0; j < 4; ++j) { g[j] = ga[j]; g[4 + j] = gb[j]; bb[j] = ba[j]; bb[4 + j] = bc[j]; } }
#pragma unroll
                for (int j = 0; j < 8; ++j) h[j] = (y[j] - mu) * rstd * g[j] + bb[j];
                const u32x4 hw = pack8(h);
                *(u32x4*)(hrow + 32 * s) = hw;
                const bf16x8 hb = __builtin_bit_cast(bf16x8, hw);
#pragma unroll
                for (int blk = 0; blk < 3; ++blk) { const bf16x8 wf = *(const LAS bf16x8*)(L + P4_WRF + ((s * 3 + blk) * 64 + lane) * 16);
                    acc[blk] = __builtin_amdgcn_mfma_f32_16x16x32_bf16(wf, hb, acc[blk], 0, 0, 0); }
            }
#pragma unroll
            for (int j = 0; j < 4; ++j) { LG[fr * 32 + 4 * q + j] = acc[1][j]; LG[fr * 32 + 16 + 4 * q + j] = acc[2][j]; }
            LDS_WAIT(); asm volatile("" ::: "memory");
            if (q == 0) {
                float gl[4]; int g = 0; float gm = -3.4e38f;
#pragma unroll
                for (int j = 0; j < 4; ++j) { gl[j] = acc[0][j] + bgrp[j]; if (gl[j] > gm) { gm = gl[j]; g = j; } }
                float se = 0.f;
#pragma unroll
                for (int j = 0; j < 4; ++j) se += __expf(gl[j] - gm);
                const float pg = 1.f / se;
                const f32x4 la = *(const LAS f32x4*)(LG + fr * 32 + 8 * g), lb = *(const LAS f32x4*)(LG + fr * 32 + 8 * g + 4);
                const f32x4 ba = *(const f32x4*)(bexp + 8 * g), bc = *(const f32x4*)(bexp + 8 * g + 4);
                float el[8];
#pragma unroll
                for (int j = 0; j < 4; ++j) { el[j] = la[j] + ba[j]; el[4 + j] = lb[j] + bc[j]; }
                int i0 = -1, i1 = -1; float v0 = -3.4e38f, v1 = -3.4e38f;
#pragma unroll
                for (int j = 0; j < 8; ++j) { const float v = el[j];
                    if (v > v0) { v1 = v0; i1 = i0; v0 = v; i0 = j; } else if (v > v1) { v1 = v; i1 = j; } }
                const float ex = __expf(v1 - v0);
                const float p0 = 1.f / (1.f + ex);
                g0 = pg * p0; g1 = pg * (ex * p0);
                e0 = g * 8 + i0; e1 = g * 8 + i1;
                r0 = __hip_atomic_fetch_add(&hist[e0], 1, __ATOMIC_RELAXED, __HIP_MEMORY_SCOPE_WORKGROUP); r1 = __hip_atomic_fetch_add(&hist[e1], 1, __ATOMIC_RELAXED, __HIP_MEMORY_SCOPE_WORKGROUP);
            }
        }
        __syncthreads();
        if (tid < 32) { const int hcnt = hist[tid]; basep[tid] = hcnt ? (int)__hip_atomic_fetch_add(cnt + tid, (unsigned)hcnt, RLX_AGENT) : 0; }
        __syncthreads();
        if (active && q == 0) {
            const int p0 = basep[e0] + r0, p1 = basep[e1] + r1;
            list[e0 * CAP + p0] = 2 * tok; list[e1 * CAP + p1] = 2 * tok + 1;
            tokgate[2 * tok] = g0; tokgate[2 * tok + 1] = g1;
        }
    }
}

__device__ __forceinline__ int moe_tables(const Frame& F, int layer) {
    LAS int* tbl = (LAS int*)(F.lds + SMALL_OFF + 1024);
    const unsigned* cnt = WSP(const unsigned, WS_CTL) + CW_CNT + 64 * layer;
    __syncthreads();
    if (F.tid < 32) tbl[F.tid] = (int)__hip_atomic_load(cnt + F.tid, RLX_AGENT);
    __syncthreads();
    if (F.tid == 0) { int s = 0; for (int e = 0; e < NE; ++e) { tbl[32 + e] = s; s += (tbl[e] + 255) >> 8; } tbl[64] = s; }
    __syncthreads();
    return 4 * tbl[64];
}

template <bool FINAL>
__device__ __forceinline__ void p7_combine(const Frame& F, const Args& A, int layer, const bf16_t* h1, const bf16_t* cbuf, bf16_t* h2, float* out) {
    const int lane = F.lane, gw = F.bid * 8 + F.wave, NGW = F.G * 8;
    const float* lng = A.in[21] + (size_t)(layer * 2 + 1) * D; const float* lnb = A.in[22] + (size_t)(layer * 2 + 1) * D;
    float g[16], bb[16];
#pragma unroll
    for (int hx = 0; hx < 2; ++hx) { const int c0 = hx * 512 + lane * 8;
        const f32x4 ga = *(const f32x4*)(lng + c0), gb = *(const f32x4*)(lng + c0 + 4), ba = *(const f32x4*)(lnb + c0), bc = *(const f32x4*)(lnb + c0 + 4);
#pragma unroll
        for (int j = 0; j < 4; ++j) { g[hx * 8 + j] = ga[j]; g[hx * 8 + 4 + j] = gb[j]; bb[hx * 8 + j] = ba[j]; bb[hx * 8 + 4 + j] = bc[j]; } }
    const int ntok = FINAL ? TREAL : NTOK;
#pragma unroll 2
    for (int t = gw; t < ntok; t += NGW) {
        float y[16];
#pragma unroll
        for (int hx = 0; hx < 2; ++hx) { const int c0 = hx * 512 + lane * 8;
            float a[8], c0v[8], c1v[8];
            unpack8(*(const u32x4*)(h1 + (size_t)t * D + c0), a);
            unpack8(*(const u32x4*)(cbuf + (size_t)(2 * t) * D + c0), c0v);
            unpack8(*(const u32x4*)(cbuf + (size_t)(2 * t + 1) * D + c0), c1v);
#pragma unroll
            for (int j = 0; j < 8; ++j) y[hx * 8 + j] = ALPHA * a[j] + (c0v[j] + c1v[j]); }
        float s = 0.f;
#pragma unroll
        for (int j = 0; j < 16; ++j) s += y[j];
        const float mu = wave_sum(s) * (1.f / D);
        float qv = 0.f;
#pragma unroll
        for (int j = 0; j < 16; ++j) { y[j] -= mu; qv += y[j] * y[j]; }
        const float rstd = __builtin_amdgcn_rsqf(wave_sum(qv) * (1.f / D) + LN_EPS);
#pragma unroll
        for (int j = 0; j < 16; ++j) y[j] = y[j] * rstd * g[j] + bb[j];
#pragma unroll
        for (int hx = 0; hx < 2; ++hx) { const int c0 = hx * 512 + lane * 8;
            if (FINAL) { *(f32x4*)(out + (size_t)t * D + c0) = (f32x4){y[hx * 8 + 0], y[hx * 8 + 1], y[hx * 8 + 2], y[hx * 8 + 3]};
                         *(f32x4*)(out + (size_t)t * D + c0 + 4) = (f32x4){y[hx * 8 + 4], y[hx * 8 + 5], y[hx * 8 + 6], y[hx * 8 + 7]}; }
            else { float o[8];
#pragma unroll
                for (int j = 0; j < 8; ++j) o[j] = y[hx * 8 + j];
                *(u32x4*)(h2 + (size_t)t * D + c0) = pack8(o); } }
    }
}

__device__ __forceinline__ void p9_convgate(const Frame& F, const Args& A, const bf16_t* bg, const bf16_t* z, bf16_t* g1) {
    const float* cw = A.in[12];
    const int gt = F.bid * 512 + F.tid, NT = F.G * 512;
    for (int item = gt; item < (TREAL / 16) * 128; item += NT) {
        const int pc = item & 127, run = item >> 7, r0 = run * 16, c0 = pc * 8;
        float w0[8], w1[8], w2[8];
        { const f32x4 a = *(const f32x4*)(cw + c0), b = *(const f32x4*)(cw + c0 + 4), c = *(const f32x4*)(cw + D + c0), d = *(const f32x4*)(cw + D + c0 + 4), e = *(const f32x4*)(cw + 2 * D + c0), f = *(const f32x4*)(cw + 2 * D + c0 + 4);
#pragma unroll
          for (int j = 0; j < 4; ++j) { w0[j] = a[j]; w0[4 + j] = b[j]; w1[j] = c[j]; w1[4 + j] = d[j]; w2[j] = e[j]; w2[4 + j] = f[j]; } }
        const bool first = (r0 & (SEQ - 1)) == 0;
        const size_t rm1 = first ? (size_t)(TREAL + NMETA - 1) : (size_t)(r0 - 1), rm2 = first ? (size_t)(TREAL + NMETA - 2) : (size_t)(r0 - 2);
        float z1[8], z2[8];
        unpack8(*(const u32x4*)(z + rm1 * D + c0), z1); unpack8(*(const u32x4*)(z + rm2 * D + c0), z2);
#pragma unroll 4
        for (int j = 0; j < 16; ++j) {
            float z0[8], b[8], o[8];
            unpack8(*(const u32x4*)(z + (size_t)(r0 + j) * D + c0), z0); unpack8(*(const u32x4*)(bg + (size_t)(r0 + j) * D + c0), b);
#pragma unroll
            for (int i = 0; i < 8; ++i) { o[i] = b[i] * (w0[i] * z2[i] + w1[i] * z1[i] + w2[i] * z0[i]); z2[i] = z1[i]; z1[i] = z0[i]; }
            *(u32x4*)(g1 + (size_t)(r0 + j) * D + c0) = pack8(o);
        }
    }
}
#define XB_TMO      128
#define XB_XCNT(j)  (256  + 64 * (j))
#define XB_XSUB(j)  (1280 + 64 * (j))
#define XB_XGEN(j)  (2304 + 64 * (j))
#define XB_TOP      3328
#define XB_TOPGEN   3392
#define XCD_BAR_WORDS 3456
#define XB_SPIN_CAP (1u << 20)
__device__ __forceinline__ unsigned xb_ld(unsigned* p)              { return __hip_atomic_load(p, __ATOMIC_RELAXED, __HIP_MEMORY_SCOPE_AGENT); }
__device__ __forceinline__ unsigned xb_add(unsigned* p, unsigned v) { return __hip_atomic_fetch_add(p, v, __ATOMIC_RELAXED, __HIP_MEMORY_SCOPE_AGENT); }
__device__ __forceinline__ unsigned xb_xcc_id() { return (unsigned)__builtin_amdgcn_s_getreg((3 << 11) | 20) & 0xFu; }
#define XB_SPIN(cond, bar) do { unsigned _sp = 0; while (cond) { __builtin_amdgcn_s_sleep(1); \
    if ((++_sp & 255u) == 0u) { if (xb_ld(&(bar)[XB_TMO])) break; if (_sp > XB_SPIN_CAP) { atomicAdd(&(bar)[XB_TMO], 1u); break; } } } } while (0)
struct XcdBarrier { unsigned* bar; unsigned x; volatile LAS unsigned* st; };
__device__ __forceinline__ XcdBarrier xcd_barrier_post(unsigned* bar, volatile LAS unsigned* st) {
    XcdBarrier b; b.bar = bar; b.x = xb_xcc_id(); b.st = st;
    if (threadIdx.x == 0) (void)xb_add(&bar[XB_XCNT(b.x)], 1u);
    return b;
}
__device__ __forceinline__ void xcd_barrier_complete(unsigned* bar, unsigned x, unsigned& nloc, unsigned& nx) {
    const unsigned G = gridDim.x * gridDim.y * gridDim.z;
    unsigned sum, cnt, mine, sp = 0u;
    for (;;) {
        sum = 0u; cnt = 0u; mine = 0u;
#pragma unroll
        for (unsigned j = 0; j < 16; ++j) { const unsigned c = xb_ld(&bar[XB_XCNT(j)]); sum += c; cnt += (c > 0u) ? 1u : 0u; mine = (j == x) ? c : mine; }
        if (sum == G) break;
        __builtin_amdgcn_s_sleep(1);
        if ((++sp & 255u) == 0u) { if (xb_ld(&bar[XB_TMO])) break; if (sp > XB_SPIN_CAP) { atomicAdd(&bar[XB_TMO], 1u); break; } }
    }
    nloc = mine > 0u ? mine : 1u; nx = cnt > 0u ? cnt : 1u;
}
__device__ __forceinline__ void xcd_barrier(const XcdBarrier& b) {
    asm volatile("s_waitcnt vmcnt(0)" ::: "memory");
    __syncthreads();
    if (threadIdx.x == 0) {
        unsigned* bar = b.bar;
        __builtin_amdgcn_s_waitcnt(0);
        unsigned nloc = b.st[0], nx = b.st[1];
        if (nloc == 0u) { xcd_barrier_complete(bar, b.x, nloc, nx); b.st[0] = nloc; b.st[1] = nx; }
        const unsigned old = xb_add(&bar[XB_XSUB(b.x)], 1u);
        const unsigned gen = old / nloc;
        if (old + 1u == (gen + 1u) * nloc) {
            __builtin_amdgcn_fence(__ATOMIC_RELEASE, "agent");
            asm volatile("s_waitcnt vmcnt(0)" ::: "memory");
            const unsigned og = xb_add(&bar[XB_TOP], 1u);
            const unsigned tg = og / nx;
            if (og + 1u == (tg + 1u) * nx) xb_add(&bar[XB_TOPGEN], 1u);
            else XB_SPIN(xb_ld(&bar[XB_TOPGEN]) == tg, bar);
            __builtin_amdgcn_fence(__ATOMIC_ACQUIRE, "agent");
            xb_add(&bar[XB_XGEN(b.x)], 1u);
            asm volatile("s_waitcnt vmcnt(0)" ::: "memory");
        } else {
            XB_SPIN(xb_ld(&bar[XB_XGEN(b.x)]) == gen, bar);
            __builtin_amdgcn_fence(__ATOMIC_ACQUIRE, "agent");
            asm volatile("s_waitcnt vmcnt(0)" ::: "memory");
        }
    }
    __syncthreads();
}

constexpr int DBG_NS = 4096, DBG_SLOTS = 16;
__host__ __device__ __forceinline__ void dbg_rc(int i, int nrows, int& r, int& c) {
    const unsigned h = (unsigned)i * 2654435761u;
    c = (int)((h >> 9) & 1023u);
    if (i < 64) { const int sp[8] = {0, 1, 2, 8192, 8193, 32768, 32783, 32767}; r = sp[i & 7] % nrows; }
    else r = (int)(((unsigned)i * 40503u + (h >> 20)) % (unsigned)nrows);
}
__device__ __forceinline__ void dbg_sample_bf16(const Frame& F, int slot, const bf16_t* buf, int nrows) {
    float* dg = (float*)(F.ws + WS_DIGEST) + (size_t)slot * DBG_NS;
    for (int i = F.bid * 512 + F.tid; i < DBG_NS; i += F.G * 512) { int r, c; dbg_rc(i, nrows, r, c); dg[i] = bf1(buf[(size_t)r * D + c]); }
}
__device__ __forceinline__ void dbg_sample_c(const Frame& F, int slot, const bf16_t* cbuf) {
    float* dg = (float*)(F.ws + WS_DIGEST) + (size_t)slot * DBG_NS;
    for (int i = F.bid * 512 + F.tid; i < DBG_NS; i += F.G * 512) { int r, c; dbg_rc(i, NTOK, r, c); dg[i] = bf1(cbuf[(size_t)(2 * r + (i & 1)) * D + c]); }
}
__device__ __forceinline__ void dbg_sample_gate(const Frame& F, int slot) {
    float* dg = (float*)(F.ws + WS_DIGEST) + (size_t)slot * DBG_NS; const float* tg = (const float*)(F.ws + WS_TOKGATE);
    for (int i = F.bid * 512 + F.tid; i < DBG_NS; i += F.G * 512) { int r, c; dbg_rc(i, NTOK, r, c); dg[i] = tg[2 * r + (i & 1)]; }
}

__global__ void __launch_bounds__(512, 2) mk_fwd(Args args) {
    extern __shared__ __attribute__((aligned(16))) unsigned char lds_raw[];
    Frame F;
    F.lds = (LAS unsigned char*)lds_raw;
    F.tid = threadIdx.x; F.lane = F.tid & 63; F.wave = __builtin_amdgcn_readfirstlane(F.tid >> 6);
    F.G = gridDim.x; F.bid = blockIdx.x;
    F.ws = args.ws;
    volatile LAS unsigned* MISC = (volatile LAS unsigned*)(F.lds + MISC_OFF);
    if (F.tid < 64) MISC[F.tid] = 0u;
    __syncthreads();
    XcdBarrier bar; bar.bar = (unsigned*)(F.ws + WS_CTL) + CW_BAR; bar.x = 0; bar.st = nullptr;
    if (MK_N_LAUNCHES == 1) bar = xcd_barrier_post((unsigned*)(F.ws + WS_CTL) + CW_BAR, MISC + 8);
    const int lo = args.ph_lo, hi = args.ph_hi;
#define IN(k) (lo <= (k) && (k) < hi)
#define SEAM(k) do { if (IN(k) && IN((k) + 1)) xcd_barrier(bar); } while (0)
    bf16_t* RA = WSP(bf16_t, WS_RA); bf16_t* RBb = WSP(bf16_t, WS_RB); bf16_t* RC = WSP(bf16_t, WS_RC); bf16_t* RE = WSP(bf16_t, WS_RE);
    LAS int* tbl = (LAS int*)(F.lds + SMALL_OFF + 1024);

    if (IN(0)) { p0_prologue(F, args); } SEAM(0);
    if (IN(1)) {
        ProbIn0 P; P.Abase = (const char*)RA; P.ord.init(R / 256, 8, F.G, F.bid); P.Bt = (const char*)(F.ws + WS_WIN0); P.ybr = RBb; P.xraw = RC;
        pg8::gemm_phase(F.lds, P);
    } SEAM(1);
    if (IN(2)) { if (MK_DEBUG_ORACLE) { dbg_sample_bf16(F, 0, RBb, NTOK); dbg_sample_bf16(F, 1, RC, NTOK); } p2_lru<false>(F, args); } SEAM(2);
    if (IN(3)) { p2_lru<true>(F, args); } SEAM(3);
    if (IN(4)) {
        if (MK_DEBUG_ORACLE) dbg_sample_bf16(F, 2, RA, NTOK);
        ProbOut<true> P; P.Abase = (const char*)RA; P.ord.init(R / 256, 4, F.G, F.bid); P.Bt = (const char*)(F.ws + WS_WOUT0); P.y1 = RBb; P.stats = WSP(f32x2, WS_STATS);
        P.x = args.in[0]; P.meta = args.in[1]; P.hres = nullptr;
        pg8::gemm_phase(F.lds, P);
    } SEAM(4);
    if (IN(5)) { if (MK_DEBUG_ORACLE) dbg_sample_bf16(F, 3, RBb, NTOK); p4_ln_route(F, args, 0, RBb, RC); } SEAM(5);
    if (IN(6)) {
        if (MK_DEBUG_ORACLE) { dbg_sample_bf16(F, 4, RC, NTOK); dbg_sample_gate(F, 5); }
        const int total = moe_tables(F, 0);
        ProbUp P; P.Abase = (const char*)RC; P.ord.tbl = tbl; P.ord.c = F.bid; P.ord.total = total; P.gu = (const char*)(F.ws + WS_GU); P.list = WSP(const int, WS_LIST); P.hid = RA;
        pg8::gemm_phase(F.lds, P);
    } SEAM(6);
    if (IN(7)) {
        const int total = moe_tables(F, 0);
        ProbDown P; P.Abase = (const char*)RA; P.ord.tbl = tbl; P.ord.c = F.bid; P.ord.total = total; P.dn = (const char*)(F.ws + WS_DN); P.list = WSP(const int, WS_LIST); P.tokgate = WSP(const float, WS_TOKGATE); P.cbuf = RE;
        pg8::gemm_phase(F.lds, P);
    } SEAM(7);
    if (IN(8)) {
        if (MK_DEBUG_ORACLE) dbg_sample_c(F, 6, RE);
        p7_combine<false>(F, args, 0, RC, RE, RA, nullptr);
        LAS float* scr = (LAS float*)(F.lds + F.wave * 8448);
        for (int it = F.bid * 8 + F.wave; it < NE * 768; it += F.G * 8) transpose_moe_item(F, args, 1, it, scr, F.lane);
    } SEAM(8);
    if (IN(9)) {
        if (MK_DEBUG_ORACLE) dbg_sample_bf16(F, 7, RA, NTOK);
        ProbIn1 P; P.Abase = (const char*)RA; P.ord.init(R / 256, 12, F.G, F.bid); P.Bt = (const char*)(F.ws + WS_WIN1); P.bg = RBb; P.z = RC;
        pg8::gemm_phase(F.lds, P);
    } SEAM(9);
    if (IN(10)) { if (MK_DEBUG_ORACLE) { dbg_sample_bf16(F, 8, RBb, NTOK); dbg_sample_bf16(F, 9, RC, NTOK); } p9_convgate(F, args, RBb, RC, RE); } SEAM(10);
    if (IN(11)) {
        if (MK_DEBUG_ORACLE) dbg_sample_bf16(F, 10, RE, TREAL);
        ProbOut<false> P; P.Abase = (const char*)RE; P.ord.init(R / 256, 4, F.G, F.bid); P.Bt = (const char*)(F.ws + WS_WOUT1); P.y1 = RBb; P.stats = WSP(f32x2, WS_STATS);
        P.x = nullptr; P.meta = nullptr; P.hres = RA;
        pg8::gemm_phase(F.lds, P);
    } SEAM(11);
    if (IN(12)) { if (MK_DEBUG_ORACLE) dbg_sample_bf16(F, 11, RBb, TREAL); p4_ln_route(F, args, 1, RBb, RC); } SEAM(12);
    if (IN(13)) {
        if (MK_DEBUG_ORACLE) { dbg_sample_bf16(F, 12, RC, TREAL); dbg_sample_gate(F, 13); }
        const int total = moe_tables(F, 1);
        ProbUp P; P.Abase = (const char*)RC; P.ord.tbl = tbl; P.ord.c = F.bid; P.ord.total = total; P.gu = (const char*)(F.ws + WS_GU); P.list = WSP(const int, WS_LIST); P.hid = RA;
        pg8::gemm_phase(F.lds, P);
    } SEAM(13);
    if (IN(14)) {
        const int total = moe_tables(F, 1);
        ProbDown P; P.Abase = (const char*)RA; P.ord.tbl = tbl; P.ord.c = F.bid; P.ord.total = total; P.dn = (const char*)(F.ws + WS_DN); P.list = WSP(const int, WS_LIST); P.tokgate = WSP(const float, WS_TOKGATE); P.cbuf = RE;
        pg8::gemm_phase(F.lds, P);
    } SEAM(14);
    if (IN(15)) { if (MK_DEBUG_ORACLE) dbg_sample_c(F, 14, RE); p7_combine<true>(F, args, 1, RC, RE, nullptr, args.out); }
#undef IN
#undef SEAM
}
#if MK_DEBUG_ORACLE
static void dbg_oracle(void* const* d_in, void* d_out, void* d_ws, hipStream_t st);
#endif
extern "C" void kernel_launch(void* const* d_in, const int* in_sizes, int n_in, void* d_out, int out_size, void* d_ws, size_t ws_size, hipStream_t stream) {
    static int grid = 0;
    if (grid == 0) {
        int dev = 0, cus = 0;
        if (hipGetDevice(&dev) != hipSuccess || hipDeviceGetAttribute(&cus, hipDeviceAttributeMultiprocessorCount, dev) != hipSuccess) { fprintf(stderr, "kernel_launch: device query failed\n"); grid = -1; return; }
        if (hipFuncSetAttribute((const void*)mk_fwd, hipFuncAttributeMaxDynamicSharedMemorySize, LDS_BYTES) != hipSuccess) { fprintf(stderr, "kernel_launch: hipFuncSetAttribute failed\n"); grid = -1; return; }
        int per_cu = 0;
        if (hipOccupancyMaxActiveBlocksPerMultiprocessor(&per_cu, (const void*)mk_fwd, 512, LDS_BYTES) != hipSuccess || per_cu < 1) fprintf(stderr, "kernel_launch: occupancy query reports %d blocks per CU\n", per_cu);
        (void)hipGetLastError();
        grid = cus;
        if (n_in != 23 || ws_size < WS_END) fprintf(stderr, "kernel_launch: unexpected n_in %d / ws_size %zu (need %zu)\n", n_in, ws_size, (size_t)WS_END);
    }
    if (grid < 0) return;
    (void)hipMemsetAsync((char*)d_ws + WS_CTL, 0, CTL_ZERO_BYTES, stream);
    Args a{};
    for (int i = 0; i < 23; ++i) a.in[i] = (const float*)d_in[i];
    a.out = (float*)d_out; a.ws = (unsigned char*)d_ws;
    if (MK_N_LAUNCHES == 1) {
        a.ph_lo = 0; a.ph_hi = 16;
        hipLaunchKernelGGL(mk_fwd, dim3(grid), dim3(512), LDS_BYTES, stream, a);
    } else {
        for (int p = 0; p < 16; ++p) { a.ph_lo = p; a.ph_hi = p + 1; hipLaunchKernelGGL(mk_fwd, dim3(grid), dim3(512), LDS_BYTES, stream, a); }
    }
#if MK_DEBUG_ORACLE
    dbg_oracle(d_in, d_out, d_ws, stream);
#endif
}
```

```cpp
#include <hip/hip_runtime.h>
#include <cstdio>
#include <cstdint>

#ifndef MK_N_LAUNCHES
#define MK_N_LAUNCHES 1
#endif
#ifndef MK_DEBUG_ORACLE
#define MK_DEBUG_ORACLE 0
#endif

#define GAS __attribute__((address_space(1)))
#define LAS __attribute__((address_space(3)))
typedef unsigned short bf16_t;
typedef short bf16x8 __attribute__((ext_vector_type(8)));
typedef float f32x4 __attribute__((ext_vector_type(4)));
typedef float f32x2 __attribute__((ext_vector_type(2)));
typedef unsigned u32x4 __attribute__((ext_vector_type(4)));
typedef unsigned u32x2 __attribute__((ext_vector_type(2)));
typedef GAS unsigned gu32;

constexpr int D = 1024, NB = 4, SEQ = 8192, NMETA = 16;
constexpr int TREAL = NB * SEQ;
constexpr int NTOK = TREAL + NMETA;
constexpr int R = 33024;
constexpr int NE = 32, NG = 4, DE = 512;
constexpr int CAP = 32800;
constexpr int MAXMT = 288;
constexpr int HIDROWS = MAXMT * 256 + 256;
constexpr float ALPHA = 1.41421356237309515f;
constexpr float LN_EPS = 1e-5f;
constexpr int NPHASES = 15;

constexpr size_t MiB = 1u << 20;
constexpr size_t WS_CTL = 0, CTL_ZERO_BYTES = 32768;
constexpr size_t WS_LIST = 1 * MiB;
constexpr size_t WS_TOKGATE = 6 * MiB + 128 * 1024;
constexpr size_t WS_STATS = 6 * MiB + 512 * 1024;
constexpr size_t WS_SCANSUM = 5 * MiB + 64 * 1024;
constexpr size_t WS_WRF = 11 * MiB + 256 * 1024;
constexpr size_t WS_WAT = 11 * MiB + 512 * 1024;
constexpr size_t WS_WIN0 = 12 * MiB;
constexpr size_t WS_WOUT0 = 16 * MiB;
constexpr size_t WS_WIN1 = 18 * MiB;
constexpr size_t WS_WOUT1 = 24 * MiB;
constexpr size_t WS_GU = 26 * MiB;
constexpr size_t WS_DN = 90 * MiB;
constexpr size_t RB_BYTES = (size_t)R * D * 2;
constexpr size_t WS_RA = 122 * MiB;
constexpr size_t WS_RB = WS_RA + RB_BYTES;
constexpr size_t WS_RC = WS_RB + RB_BYTES;
constexpr size_t WS_RE = WS_RC + RB_BYTES;
constexpr size_t WS_END = WS_RE + 2 * RB_BYTES;
static_assert((size_t)HIDROWS * DE * 2 <= 2 * RB_BYTES, "HID fits RA+RB");
static_assert(WS_STATS + (size_t)R * 16 * 8 <= WS_WRF && WS_LIST + (size_t)NE * CAP * 4 <= WS_SCANSUM && WS_SCANSUM + (1u << 20) <= WS_TOKGATE && WS_TOKGATE + (size_t)2 * R * 4 <= WS_STATS, "small buffers");
constexpr size_t WS_GU1 = WS_END;
constexpr size_t WS_DN1 = WS_GU1 + 64 * MiB;
constexpr size_t WS_END2 = WS_DN1 + 32 * MiB;
constexpr size_t WS_DIGEST = WS_END2;
constexpr int CW_CNT = 64;
constexpr int CW_DBG = 256;
constexpr int CW_BAR = 4096;
constexpr int CW_MOE = 32768;
constexpr int CW_TMO = 16;

constexpr int RING_BYTES = 131072;
constexpr int SMALL_OFF = RING_BYTES;
constexpr int MISC_OFF = 160 * 1024 - 2048;
constexpr int LDS_BYTES = 160 * 1024;

#define RLX_AGENT __ATOMIC_RELAXED, __HIP_MEMORY_SCOPE_AGENT
#define LDS_WAIT() asm volatile("s_waitcnt lgkmcnt(0)" ::: "memory")
#define VM_WAIT() asm volatile("s_waitcnt vmcnt(0)" ::: "memory")

__device__ __forceinline__ unsigned cvt_pk_bf16(float lo, float hi) { unsigned r; asm volatile("v_cvt_pk_bf16_f32 %0, %1, %2" : "=v"(r) : "v"(lo), "v"(hi)); return r; }
__device__ __forceinline__ float bf_lo(unsigned w) { return __builtin_bit_cast(float, w << 16); }
__device__ __forceinline__ float bf_hi(unsigned w) { return __builtin_bit_cast(float, w & 0xffff0000u); }
__device__ __forceinline__ float bf1(unsigned short h) { return __builtin_bit_cast(float, ((unsigned)h) << 16); }
__device__ __forceinline__ void unpack8(const u32x4 w, float (&f)[8]) {
    f[0] = bf_lo(w.x); f[1] = bf_hi(w.x); f[2] = bf_lo(w.y); f[3] = bf_hi(w.y); f[4] = bf_lo(w.z); f[5] = bf_hi(w.z); f[6] = bf_lo(w.w); f[7] = bf_hi(w.w);
}
__device__ __forceinline__ u32x4 pack8(const float (&f)[8]) {
    u32x4 w; w.x = cvt_pk_bf16(f[0], f[1]); w.y = cvt_pk_bf16(f[2], f[3]); w.z = cvt_pk_bf16(f[4], f[5]); w.w = cvt_pk_bf16(f[6], f[7]); return w;
}
__device__ __forceinline__ float fast_sigmoid(float x) { return __builtin_amdgcn_rcpf(1.0f + __builtin_amdgcn_exp2f(-1.44269504089f * x)); }
__device__ __forceinline__ float gelu_tanh_f(float x) {
    const float z2 = 1.5957691216f * (x + 0.044715f * x * x * x);
    return x * fast_sigmoid(z2);
}
__device__ __forceinline__ float wave_sum(float v) {
#pragma unroll
    for (int o = 1; o < 64; o <<= 1) v += __shfl_xor(v, o);
    return v;
}
namespace pg8 {
constexpr int BM = 256, BK = 64, HALF = 128, HTB = HALF * BK * 2  , STAGE_BYTES = 8 * HTB, NXCD = 8, WGM = 8;
__host__ __device__ __forceinline__ int lds_byte(int r, int c) { const int st = (r >> 4) * 2 + (c >> 5), rr = r & 15, cc = c & 31, ob = rr * 64 + cc * 2; return st * 1024 + (ob ^ (((ob >> 9) & 1) << 5)); }
__host__ __device__ __forceinline__ void stage_rc(int b, int& R_, int& C_) { const int st = b / 1024, sb = b % 1024, swz = sb ^ (((sb >> 9) & 1) << 5); R_ = (st >> 1) * 16 + swz / 64; C_ = (st & 1) * 32 + (swz % 64) / 2; }
__host__ __device__ __forceinline__ int perm32(int rho) { const int n = rho >> 4, i = rho & 15; return 8 * (i >> 2) + 4 * n + (i & 3); }

struct Unit { int pm, pn, e, lt, hf; };

struct DenseOrder {
    int nM, nN, nwg, G, c;
    __device__ __forceinline__ void init(int nM_, int nN_, int G_, int c_) { nM = nM_; nN = nN_; nwg = nM * nN; G = G_; c = c_; }
    __device__ __forceinline__ bool next(int i, Unit& u) const {
        const long L = (long)i * G + c; if (L >= nwg) return false;
        int wgid = (int)L; { const int q = nwg / NXCD, r = nwg % NXCD, xcd = wgid % NXCD, off = wgid / NXCD; wgid = (xcd < r ? xcd * (q + 1) : r * (q + 1) + (xcd - r) * q) + off; }
        const int nig = WGM * nN, gid = wgid / nig, fm = gid * WGM, gsz = (nM - fm) < WGM ? (nM - fm) : WGM;
        u.pm = fm + ((wgid % nig) % gsz); u.pn = (wgid % nig) / gsz; u.e = 0; u.lt = 0; u.hf = 0; return true;
    }
};

template <class P>
__device__ __forceinline__ void gemm_phase(LAS unsigned char* lds, const P& prob, int probe = 0) {
    constexpr bool ALIGN_EPI = true;
    const int tid = threadIdx.x, wid = __builtin_amdgcn_readfirstlane(tid >> 6), lane = tid & 63, wr = wid >> 2, wc = wid & 3, fr = lane & 15, fq = lane >> 4;
    constexpr int K = P::K, nt = K / BK;
    int R0, C0; stage_rc(tid * 16, R0, C0);
    unsigned voffB[2];
#pragma unroll
    for (int i = 0; i < 2; ++i) { const int Rr = R0 + 64 * i; const int Rb = (Rr & ~31) + perm32(Rr & 31); voffB[i] = (unsigned)(Rb * K + C0) * 2u; }
    unsigned voffA[2][2];
    constexpr size_t kstep = (size_t)(BK * 2);
    constexpr size_t hstepB = (size_t)HALF * K * 2;
    const unsigned ldsw = (unsigned)wid * 1024u;
    const int aoff = lds_byte(wr * 64 + fr, fq * 8), boff = lds_byte(wc * 32 + fr, fq * 8);
#define PG8_SA(b, h) (((b) * 2 + (h)) * HTB)
#define PG8_SB(b, h) ((4 + (b) * 2 + (h)) * HTB)
#define PG8_STAGE(bufoff, gbase, voff) do { _Pragma("unroll") for (int _i = 0; _i < 2; ++_i) \
        __builtin_amdgcn_global_load_lds((const unsigned*)((const char*)(gbase) + (voff)[_i]), (LAS unsigned*)(lds + (bufoff) + ldsw + _i * 8192), 16, 0, 0); } while (0)
#define PG8_STAGE_A(bufoff, gbase, h) do { _Pragma("unroll") for (int _i = 0; _i < 2; ++_i) { const unsigned _va = P::GATHER ? voffA[h][_i] : (voffA[0][0] + (unsigned)(((h) * 128 + _i * 64) * K * 2)); \
        __builtin_amdgcn_global_load_lds((const unsigned*)((const char*)(gbase) + _va), (LAS unsigned*)(lds + (bufoff) + ldsw + _i * 8192), 16, 0, P::A_AUX); } } while (0)
#define PG8_LDA(dst, b, h) do { _Pragma("unroll") for (int m = 0; m < 4; ++m) _Pragma("unroll") for (int k = 0; k < 2; ++k) dst[m][k] = *(const LAS bf16x8*)(lds + PG8_SA(b, h) + aoff + m * 2048 + k * 1024); } while (0)
#define PG8_LDB(dst, b, h) do { _Pragma("unroll") for (int n = 0; n < 2; ++n) _Pragma("unroll") for (int k = 0; k < 2; ++k) dst[n][k] = *(const LAS bf16x8*)(lds + PG8_SB(b, h) + boff + n * 2048 + k * 1024); } while (0)
#define PG8_MMA(ai, bj, At, Bt) do { __builtin_amdgcn_s_setprio(1); _Pragma("unroll") for (int m = 0; m < 4; ++m) _Pragma("unroll") for (int n = 0; n < 2; ++n) _Pragma("unroll") for (int k = 0; k < 2; ++k) \
        acc[ai][bj][m][n] = __builtin_amdgcn_mfma_f32_16x16x32_bf16(Bt[n][k], At[m][k], acc[ai][bj][m][n], 0, 0, 0); __builtin_amdgcn_s_setprio(0); } while (0)
#define PG8_WAIT_V(n) asm volatile("s_waitcnt vmcnt(" #n ")" ::: "memory")
#define PG8_WAIT_L(n) asm volatile("s_waitcnt lgkmcnt(" #n ")" ::: "memory")
#define PG8_BAR __builtin_amdgcn_s_barrier()
#define PG8_SCHED __builtin_amdgcn_sched_barrier(0)
    Unit cur, nxt, prv; int ui = 0; bool have_prv = false;
    unsigned long long pr_sum = 0, pr_t0 = 0; const bool pr_on = (probe != 0) && blockIdx.x == 0 && wid == 0;
    if (!prob.next(0, cur)) return;
    f32x4 acc[2][2][4][2];
#pragma unroll
    for (int a = 0; a < 2; ++a)
#pragma unroll
        for (int b = 0; b < 2; ++b)
#pragma unroll
            for (int m = 0; m < 4; ++m)
#pragma unroll
                for (int n = 0; n < 2; ++n) acc[a][b][m][n] = (f32x4){0.f, 0.f, 0.f, 0.f};
    bf16x8 At[4][2], B0[2][2], B1[2][2];
    const char* const Ab = prob.Abase;
    const char* cB = prob.b_ptr(cur);
    prob.a_ready(cur);
    prob.a_off(cur, R0, C0 * 2, voffA);
    PG8_STAGE(PG8_SB(0, 0), cB, voffB); PG8_STAGE(PG8_SB(0, 1), cB + hstepB, voffB); PG8_STAGE_A(PG8_SA(0, 0), Ab, 0); PG8_STAGE_A(PG8_SA(0, 1), Ab, 1);
    if (wr == 1) PG8_BAR;
    PG8_WAIT_V(2); PG8_BAR;
    PG8_STAGE(PG8_SB(1, 0), cB + kstep, voffB); PG8_STAGE_A(PG8_SA(1, 0), Ab + kstep, 0); PG8_STAGE(PG8_SB(1, 1), cB + hstepB + kstep, voffB);
    PG8_WAIT_V(6); PG8_BAR;
    for (;;) {
        const bool has_next = prob.next(ui + 1, nxt);
        const char* nB = has_next ? prob.b_ptr(nxt) : cB;
#pragma nounroll
        for (int t = 0; t < nt; t += 2) {
            const bool last = (t == nt - 2);
            const char* a1 = Ab + (size_t)(t + 1) * kstep;
            const char* a2 = last ? Ab : Ab + (size_t)(t + 2) * kstep; const char* b2 = last ? nB : cB + (size_t)(t + 2) * kstep;
            const char* a3 = a2 + kstep; const char* b3 = b2 + kstep;
            if (last && has_next) prob.a_ready(nxt);
            if (pr_on && probe == 2 && t == 0) pr_t0 = __builtin_amdgcn_s_memrealtime();
            PG8_LDB(B0, 0, 0); PG8_LDB(B1, 0, 1); PG8_SCHED; PG8_LDA(At, 0, 0); PG8_STAGE_A(PG8_SA(1, 1), a1, 1);
            if (last && has_next) prob.a_off(nxt, R0, C0 * 2, voffA);
            PG8_WAIT_V(8); PG8_WAIT_L(0); PG8_BAR; if (pr_on && probe == 2 && t == 0) pr_sum += __builtin_amdgcn_s_memrealtime() - pr_t0; PG8_MMA(0, 0, At, B0); PG8_MMA(0, 1, At, B1); PG8_BAR; PG8_SCHED;
            PG8_LDA(At, 0, 1); PG8_STAGE(PG8_SB(0, 0), b2, voffB); PG8_STAGE(PG8_SB(0, 1), b2 + hstepB, voffB); PG8_STAGE_A(PG8_SA(0, 0), a2, 0);
            PG8_WAIT_V(8); PG8_WAIT_L(0); PG8_BAR; if (cur.hf == 0) { PG8_MMA(1, 0, At, B0); PG8_MMA(1, 1, At, B1); } PG8_BAR; PG8_SCHED;
            PG8_LDB(B0, 1, 0); PG8_LDB(B1, 1, 1); PG8_SCHED; PG8_LDA(At, 1, 0); PG8_STAGE_A(PG8_SA(0, 1), a2, 1);
            PG8_WAIT_V(8); PG8_WAIT_L(0); PG8_BAR; PG8_MMA(0, 0, At, B0); PG8_MMA(0, 1, At, B1); PG8_BAR; PG8_SCHED;
            PG8_LDA(At, 1, 1); PG8_STAGE(PG8_SB(1, 0), b3, voffB); PG8_STAGE(PG8_SB(1, 1), b3 + hstepB, voffB); PG8_STAGE_A(PG8_SA(1, 0), a3, 0);
            PG8_WAIT_V(8); PG8_WAIT_L(0); PG8_BAR; if (cur.hf == 0) { PG8_MMA(1, 0, At, B0); PG8_MMA(1, 1, At, B1); } PG8_BAR; PG8_SCHED;
        }
        if (pr_on && probe == 1) pr_t0 = __builtin_amdgcn_s_memrealtime();
        if constexpr (ALIGN_EPI) { if (wr == 0) PG8_BAR; }
        if (have_prv) prob.done(prv);
        prob.epi(acc, cur, wr, wc, fr, fq);
        prv = cur; have_prv = true;
        if (!has_next) break;
#pragma unroll
        for (int a = 0; a < 2; ++a)
#pragma unroll
            for (int b = 0; b < 2; ++b)
#pragma unroll
                for (int m = 0; m < 4; ++m)
#pragma unroll
                    for (int n = 0; n < 2; ++n) acc[a][b][m][n] = (f32x4){0.f, 0.f, 0.f, 0.f};
        cur = nxt; cB = nB; ++ui;
        if constexpr (ALIGN_EPI) { if (wr == 1) PG8_BAR; }
        if (pr_on && probe == 1) pr_sum += __builtin_amdgcn_s_memrealtime() - pr_t0;
    }
    if (pr_on && (threadIdx.x & 63) == 0) *(volatile LAS unsigned long long*)(lds + MISC_OFF + 1024 + 8 * 20) = pr_sum;
    PG8_WAIT_V(0);
    prob.done(prv);
    if constexpr (!ALIGN_EPI) { if (wr == 0) PG8_BAR; }
    PG8_BAR;
#undef PG8_SA
#undef PG8_SB
#undef PG8_STAGE
#undef PG8_STAGE_A
#undef PG8_LDA
#undef PG8_LDB
#undef PG8_MMA
#undef PG8_WAIT_V
#undef PG8_WAIT_L
#undef PG8_BAR
#undef PG8_SCHED
}
}
using pg8::Unit;
typedef f32x4 acc_t[2][2][4][2];

struct DenseA {
    static constexpr bool GATHER = false; static constexpr int A_AUX = 0;
    const char* Abase; pg8::DenseOrder ord;
    __device__ __forceinline__ bool next(int i, Unit& u) const { return ord.next(i, u); }
    __device__ __forceinline__ void a_ready(const Unit&) const {}
    __device__ __forceinline__ void done(const Unit&) const {}
    template <int K> __device__ __forceinline__ void a_off_k(const Unit& u, int R0, int C2, unsigned (&vo)[2][2]) const {
#pragma unroll
        for (int h = 0; h < 2; ++h)
#pragma unroll
            for (int i = 0; i < 2; ++i) vo[h][i] = (unsigned)((u.pm * 256 + h * 128 + R0 + 64 * i) * K * 2 + C2);
    }
};

struct ProbIn0 : DenseA {
    static constexpr int K = 1024;
    const char* Bt; bf16_t* ybr; bf16_t* xraw;
    __device__ __forceinline__ void a_off(const Unit& u, int R0, int C2, unsigned (&vo)[2][2]) const { a_off_k<K>(u, R0, C2, vo); }
    __device__ __forceinline__ const char* b_ptr(const Unit& u) const { return Bt + (size_t)u.pn * 256 * K * 2; }
    __device__ __forceinline__ void epi(const acc_t& acc, const Unit& u, int wr, int wc, int fr, int fq) const {
        const bool left = u.pn < 4;
        bf16_t* base = left ? ybr : xraw;
        const int col0 = (u.pn & 3) * 256 + wc * 32 + 8 * fq, row0 = u.pm * 256 + wr * 64 + fr;
#pragma unroll
        for (int ai = 0; ai < 2; ++ai)
#pragma unroll
            for (int m = 0; m < 4; ++m) { bf16_t* rowp = base + (size_t)(row0 + ai * 128 + m * 16) * D + col0;
#pragma unroll
                for (int bj = 0; bj < 2; ++bj) { f32x4 v0 = acc[ai][bj][m][0], v1 = acc[ai][bj][m][1];
                    if (left) {
#pragma unroll
                        for (int j = 0; j < 4; ++j) { v0[j] = gelu_tanh_f(v0[j]); v1[j] = gelu_tanh_f(v1[j]); } }
                    u32x4 w; w.x = cvt_pk_bf16(v0[0], v0[1]); w.y = cvt_pk_bf16(v0[2], v0[3]); w.z = cvt_pk_bf16(v1[0], v1[1]); w.w = cvt_pk_bf16(v1[2], v1[3]);
                    *(u32x4*)(rowp + bj * 128) = w; } }
    }
};

template <bool RES_F32> struct ProbOut : DenseA {
    static constexpr int K = 1024;
    const char* Bt; bf16_t* y1; f32x2* stats;
    const float* x; const float* meta;
    const bf16_t* hres;
    __device__ __forceinline__ void a_off(const Unit& u, int R0, int C2, unsigned (&vo)[2][2]) const { a_off_k<K>(u, R0, C2, vo); }
    __device__ __forceinline__ const char* b_ptr(const Unit& u) const { return Bt + (size_t)u.pn * 256 * K * 2; }
    __device__ __forceinline__ void epi(const acc_t& acc, const Unit& u, int wr, int wc, int fr, int fq) const {
        const int col0 = u.pn * 256 + wc * 32 + 8 * fq, row0 = u.pm * 256 + wr * 64 + fr;
#pragma unroll
        for (int ai = 0; ai < 2; ++ai) {
            f32x4 rf[4][2][2]; u32x4 rh[4][2]; float al[4];
#pragma unroll
            for (int m = 0; m < 4; ++m) {
                const int row = row0 + ai * 128 + m * 16;
                if (RES_F32) { const int rc = row < NTOK ? row : NTOK - 1; const float* rp = ((rc < TREAL) ? (x + (size_t)rc * D) : (meta + (size_t)(rc - TREAL) * D)) + col0; al[m] = row < NTOK ? ALPHA : 0.f;
#pragma unroll
                    for (int bj = 0; bj < 2; ++bj) { rf[m][bj][0] = *(const f32x4*)(rp + bj * 128); rf[m][bj][1] = *(const f32x4*)(rp + bj * 128 + 4); } }
                else { const bf16_t* hp = hres + (size_t)row * D + col0; al[m] = ALPHA;
#pragma unroll
                    for (int bj = 0; bj < 2; ++bj) rh[m][bj] = *(const u32x4*)(hp + bj * 128); }
            }
#pragma unroll
            for (int m = 0; m < 4; ++m) {
                const int row = row0 + ai * 128 + m * 16;
                float s1 = 0.f, s2 = 0.f;
                bf16_t* rowp = y1 + (size_t)row * D + col0;
#pragma unroll
                for (int bj = 0; bj < 2; ++bj) {
                    float r8[8];
                    if (RES_F32) { const f32x4 a = rf[m][bj][0], b = rf[m][bj][1]; r8[0] = a[0]; r8[1] = a[1]; r8[2] = a[2]; r8[3] = a[3]; r8[4] = b[0]; r8[5] = b[1]; r8[6] = b[2]; r8[7] = b[3]; }
                    else unpack8(rh[m][bj], r8);
                    float v[8];
#pragma unroll
                    for (int j = 0; j < 4; ++j) { v[j] = acc[ai][bj][m][0][j] + al[m] * r8[j]; v[4 + j] = acc[ai][bj][m][1][j] + al[m] * r8[4 + j]; }
#pragma unroll
                    for (int j = 0; j < 8; ++j) { s1 += v[j]; s2 += v[j] * v[j]; }
                    *(u32x4*)(rowp + bj * 128) = pack8(v);
                }
                s1 += __shfl_xor(s1, 16); s1 += __shfl_xor(s1, 32); s2 += __shfl_xor(s2, 16); s2 += __shfl_xor(s2, 32);
                if (fq == 0) stats[(size_t)row * 16 + u.pn * 4 + wc] = (f32x2){s1, s2};
            }
        }
    }
};

struct ProbIn1 : DenseA {
    static constexpr int K = 1024;
    const char* Bt; bf16_t* bg; bf16_t* z;
    __device__ __forceinline__ void a_off(const Unit& u, int R0, int C2, unsigned (&vo)[2][2]) const { a_off_k<K>(u, R0, C2, vo); }
    __device__ __forceinline__ const char* b_ptr(const Unit& u) const { return Bt + (size_t)u.pn * 256 * K * 2; }
    __device__ __forceinline__ void epi(const acc_t& acc, const Unit& u, int wr, int wc, int fr, int fq) const {
        const int row0 = u.pm * 256 + wr * 64 + fr;
        if (u.pn < 4) {
            const int col0 = u.pn * 256 + wc * 32 + 8 * fq;
#pragma unroll
            for (int ai = 0; ai < 2; ++ai)
#pragma unroll
                for (int m = 0; m < 4; ++m) { bf16_t* rowp = bg + (size_t)(row0 + ai * 128 + m * 16) * D + col0;
#pragma unroll
                    for (int bj = 0; bj < 2; ++bj) { const f32x4 v0 = acc[ai][bj][m][0], v1 = acc[ai][bj][m][1];
                        u32x4 w; w.x = cvt_pk_bf16(v0[0], v0[1]); w.y = cvt_pk_bf16(v0[2], v0[3]); w.z = cvt_pk_bf16(v1[0], v1[1]); w.w = cvt_pk_bf16(v1[2], v1[3]);
                        *(u32x4*)(rowp + bj * 128) = w; } }
        } else {
            const int col0 = (u.pn - 4) * 128 + wc * 32 + 8 * fq;
#pragma unroll
            for (int ai = 0; ai < 2; ++ai)
#pragma unroll
                for (int m = 0; m < 4; ++m) { bf16_t* rowp = z + (size_t)(row0 + ai * 128 + m * 16) * D + col0;
                    const f32x4 v0 = acc[ai][0][m][0] * acc[ai][1][m][0], v1 = acc[ai][0][m][1] * acc[ai][1][m][1];
                    u32x4 w; w.x = cvt_pk_bf16(v0[0], v0[1]); w.y = cvt_pk_bf16(v0[2], v0[3]); w.z = cvt_pk_bf16(v1[0], v1[1]); w.w = cvt_pk_bf16(v1[2], v1[3]);
                    *(u32x4*)rowp = w; }
        }
    }
};

struct MoeOrder {
    const LAS int* tbl; int c, total;
    __device__ __forceinline__ bool next(int i, Unit& u) const {
        const int off = (c & 7) * 32 + (c >> 3);
        const int nfr = total >> 8, rem = total & 255;
        int L = i * 256 + off; u.hf = 0;
        if (rem > 0 && rem <= 128 && i == nfr) {
            if (off >= 2 * rem) return false;
            L = nfr * 256 + (off >> 1); u.hf = 1 + (off & 1);
        } else if (L >= total) return false;
        const int mt = L >> 2; u.pn = L & 3; u.pm = mt;
        int e = 0;
#pragma unroll 1
        for (int j = 1; j < NE; ++j) if (tbl[32 + j] <= mt) e = j;
        u.e = e; u.lt = mt - tbl[32 + e];
        return true;
    }
};

struct ProbUp {
    static constexpr int K = 1024; static constexpr bool GATHER = true; static constexpr int A_AUX = 0;
    const char* Abase; MoeOrder ord; const char* gu; const int* list; bf16_t* hid; unsigned* mcnt;
    __device__ __forceinline__ void a_ready(const Unit&) const {}
    __device__ __forceinline__ void done(const Unit&) const {}
    __device__ __forceinline__ bool next(int i, Unit& u) const { return ord.next(i, u); }
    __device__ __forceinline__ void a_off(const Unit& u, int R0, int C2, unsigned (&vo)[2][2]) const {
        const int cnt = ord.tbl[u.e];
#pragma unroll
        for (int h = 0; h < 2; ++h)
#pragma unroll
            for (int i = 0; i < 2; ++i) { const int rank = u.lt * 256 + (u.hf ? (u.hf - 1) * 128 : h * 128) + R0 + 64 * i;
                int tok = R - 1;
                if (rank < cnt) tok = list[u.e * CAP + rank] >> 1;
                vo[h][i] = (unsigned)(tok * (K * 2) + C2); }
    }
    __device__ __forceinline__ const char* b_ptr(const Unit& u) const { return gu + ((size_t)u.e * 1024 + (size_t)u.pn * 256) * K * 2; }
    __device__ __forceinline__ void epi(const acc_t& acc, const Unit& u, int wr, int wc, int fr, int fq) const {
        const int col0 = u.pn * 128 + wc * 32 + 8 * fq, row0 = u.pm * 256 + (u.hf == 2 ? 128 : 0) + wr * 64 + fr;
#pragma unroll
        for (int ai = 0; ai < 2; ++ai) if (ai == 0 || u.hf == 0)
#pragma unroll
            for (int m = 0; m < 4; ++m) { bf16_t* rowp = hid + (size_t)(row0 + ai * 128 + m * 16) * DE + col0;
                float v[8];
#pragma unroll
                for (int j = 0; j < 4; ++j) { const float g0 = acc[ai][0][m][0][j], g1 = acc[ai][0][m][1][j];
                    v[j] = g0 * fast_sigmoid(g0) * acc[ai][1][m][0][j]; v[4 + j] = g1 * fast_sigmoid(g1) * acc[ai][1][m][1][j]; }
                *(u32x4*)rowp = pack8(v); }
    }
};

struct ProbDown {
    static constexpr int K = 512; static constexpr bool GATHER = false; static constexpr int A_AUX = 0;
    const char* Abase; MoeOrder ord; const char* dn; const int* list; const float* tokgate; bf16_t* cbuf; unsigned* mcnt; unsigned* tmo;
    __device__ __forceinline__ void done(const Unit&) const {}
    __device__ __forceinline__ void a_ready(const Unit&) const {}
    __device__ __forceinline__ bool next(int i, Unit& u) const { return ord.next(i, u); }
    __device__ __forceinline__ void a_off(const Unit& u, int R0, int C2, unsigned (&vo)[2][2]) const {
#pragma unroll
        for (int h = 0; h < 2; ++h)
#pragma unroll
            for (int i = 0; i < 2; ++i) vo[h][i] = (unsigned)((u.pm * 256 + (u.hf == 2 ? 128 : 0) + h * 128 + R0 + 64 * i) * K * 2 + C2);
    }
    __device__ __forceinline__ const char* b_ptr(const Unit& u) const { return dn + ((size_t)u.e * 1024 + (size_t)u.pn * 256) * K * 2; }
    __device__ __forceinline__ void epi(const acc_t& acc, const Unit& u, int wr, int wc, int fr, int fq) const {
        const int cnt = ord.tbl[u.e];
        const int col0 = u.pn * 256 + wc * 32 + 8 * fq, rr0 = (u.hf == 2 ? 128 : 0) + wr * 64 + fr;
        int li[8]; float gt[8];
#pragma unroll
        for (int q = 0; q < 8; ++q) { const int rank = u.lt * 256 + rr0 + (q >> 2) * 128 + (q & 3) * 16; li[q] = list[u.e * CAP + (rank < cnt ? rank : 0)]; }
#pragma unroll
        for (int q = 0; q < 8; ++q) gt[q] = tokgate[li[q]];
#pragma unroll
        for (int ai = 0; ai < 2; ++ai)
#pragma unroll
            for (int m = 0; m < 4; ++m) {
                const int rank = u.lt * 256 + rr0 + ai * 128 + m * 16;
                const bool ok = rank < cnt && (ai == 0 || u.hf == 0);
                const float g = gt[ai * 4 + m];
                bf16_t* rowp = cbuf + (size_t)li[ai * 4 + m] * D + col0;
#pragma unroll
                for (int bj = 0; bj < 2; ++bj) { const f32x4 v0 = acc[ai][bj][m][0] * g, v1 = acc[ai][bj][m][1] * g;
                    u32x4 w; w.x = cvt_pk_bf16(v0[0], v0[1]); w.y = cvt_pk_bf16(v0[2], v0[3]); w.z = cvt_pk_bf16(v1[0], v1[1]); w.w = cvt_pk_bf16(v1[2], v1[3]);
                    if (ok) *(u32x4*)(rowp + bj * 128) = w; } }
    }
};
struct Args { const float* in[23]; float* out; unsigned char* ws; int ph_lo, ph_hi; };
struct Frame {
    LAS unsigned char* lds;
    int tid, lane, wave, bid, G;
    unsigned char* ws;
};
#define WSP(T, off) ((T*)(F.ws + (off)))

__device__ __forceinline__ void transpose_item(const float* __restrict__ W, int ldw, int k0, int n0, bf16_t* __restrict__ WT, int ldk, int drow0, LAS float* scr, int lane) {
    f32x4 v[8];
    const float* src = W + (size_t)(k0 + (lane >> 3)) * ldw + n0 + 4 * (lane & 7);
#pragma unroll
    for (int i = 0; i < 8; ++i) v[i] = __builtin_nontemporal_load((const f32x4*)(src + (size_t)(8 * i) * ldw));
#pragma unroll
    for (int i = 0; i < 8; ++i) { LAS float* d = scr + ((lane >> 3) + 8 * i) * 33 + 4 * (lane & 7); d[0] = v[i][0]; d[1] = v[i][1]; d[2] = v[i][2]; d[3] = v[i][3]; }
    LDS_WAIT(); asm volatile("" ::: "memory");
    const int c = lane & 7;
#pragma unroll
    for (int j = 0; j < 4; ++j) { const int n = (lane >> 3) + 8 * j; const LAS float* s = scr + (8 * c) * 33 + n;
        u32x4 o; o.x = cvt_pk_bf16(s[0 * 33], s[1 * 33]); o.y = cvt_pk_bf16(s[2 * 33], s[3 * 33]); o.z = cvt_pk_bf16(s[4 * 33], s[5 * 33]); o.w = cvt_pk_bf16(s[6 * 33], s[7 * 33]);
        *(u32x4*)(WT + (size_t)(drow0 + n) * ldk + k0 + 8 * c) = o; }
    LDS_WAIT(); asm volatile("" ::: "memory");
}
template <int MAP> __device__ __forceinline__ void transpose_dense_item(const float* W, int K, int N, bf16_t* WT, int item, LAS float* scr, int lane) {
    const int nblk = N / 32, kb = item / nblk, nb = item % nblk, n0 = nb * 32;
    int drow = n0;
    if (MAP == 1 && n0 >= 1024) { const int s = (n0 >= 2048) ? 1 : 0, j = n0 - 1024 - 1024 * s; drow = 1024 + 256 * (j >> 7) + 128 * s + (j & 127); }
    transpose_item(W, N, kb * 64, n0, WT, K, drow, scr, lane);
}
__device__ __forceinline__ void tr_issue(const float* __restrict__ W, int ldw, int k0, int n0, f32x4 (&v)[8], int lane) {
    const float* src = W + (size_t)(k0 + (lane >> 3)) * ldw + n0 + 4 * (lane & 7);
#pragma unroll
    for (int i = 0; i < 8; ++i) v[i] = __builtin_nontemporal_load((const f32x4*)(src + (size_t)(8 * i) * ldw));
}
__device__ __forceinline__ void tr_to_lds(const f32x4 (&v)[8], LAS float* scr, int lane) {
#pragma unroll
    for (int i = 0; i < 8; ++i) { LAS float* d = scr + ((lane >> 3) + 8 * i) * 33 + 4 * (lane & 7); d[0] = v[i][0]; d[1] = v[i][1]; d[2] = v[i][2]; d[3] = v[i][3]; }
}
__device__ __forceinline__ void tr_from_lds(bf16_t* __restrict__ WT, int ldk, int drow0, int k0, LAS float* scr, int lane) {
    LDS_WAIT(); asm volatile("" ::: "memory");
    const int c = lane & 7;
#pragma unroll
    for (int j = 0; j < 4; ++j) { const int n = (lane >> 3) + 8 * j; const LAS float* s = scr + (8 * c) * 33 + n;
        u32x4 o; o.x = cvt_pk_bf16(s[0 * 33], s[1 * 33]); o.y = cvt_pk_bf16(s[2 * 33], s[3 * 33]); o.z = cvt_pk_bf16(s[4 * 33], s[5 * 33]); o.w = cvt_pk_bf16(s[6 * 33], s[7 * 33]);
        *(u32x4*)(WT + (size_t)(drow0 + n) * ldk + k0 + 8 * c) = o; }
    LDS_WAIT(); asm volatile("" ::: "memory");
}
__device__ __forceinline__ void tr_finish(const f32x4 (&v)[8], bf16_t* __restrict__ WT, int ldk, int drow0, int k0, LAS float* scr, int lane) { tr_to_lds(v, scr, lane); tr_from_lds(WT, ldk, drow0, k0, scr, lane); }
struct MoeItem { const float* W; bf16_t* WT; int ldw, ldk, k0, n0, drow0; };
constexpr int MOE_IDS = 2 * NE * 768;
constexpr int DN_WOUT0 = 16 * 32, DN_WIN1 = 16 * 96, DN_WOUT1 = 16 * 32;
constexpr int ALL_IDS = MOE_IDS + DN_WOUT0 + DN_WIN1 + DN_WOUT1;
__device__ __forceinline__ MoeItem moe_item(const Frame& F, const Args& A, int id) {
    MoeItem m;
    if (id >= MOE_IDS) {
        int r = id - MOE_IDS; int N; int map = 0;
        if (r < DN_WOUT0) { m.W = A.in[10]; N = D; m.WT = WSP(bf16_t, WS_WOUT0); }
        else if (r < DN_WOUT0 + DN_WIN1) { r -= DN_WOUT0; m.W = A.in[11]; N = 3072; m.WT = WSP(bf16_t, WS_WIN1); map = 1; }
        else { r -= DN_WOUT0 + DN_WIN1; m.W = A.in[13]; N = D; m.WT = WSP(bf16_t, WS_WOUT1); }
        const int nblk = N / 32, kb = r / nblk, nb = r % nblk; m.ldw = N; m.ldk = D; m.k0 = kb * 64; m.n0 = nb * 32; m.drow0 = m.n0;
        if (map == 1 && m.n0 >= 1024) { const int s2 = (m.n0 >= 2048) ? 1 : 0, j = m.n0 - 1024 - 1024 * s2; m.drow0 = 1024 + 256 * (j >> 7) + 128 * s2 + (j & 127); }
        return m;
    }
    const int layer = id / (NE * 768), item = id % (NE * 768);
    const int e = item / 768, r = item % 768, kind = r >> 8, q = r & 255;
    if (kind < 2) {
        m.W = (kind ? A.in[19] : A.in[18]) + ((size_t)layer * NE + e) * D * DE; m.ldw = DE;
        m.k0 = (q >> 4) * 64; m.n0 = (q & 15) * 32; m.WT = WSP(bf16_t, layer ? WS_GU1 : WS_GU) + (size_t)e * 1024 * 1024; m.ldk = D; m.drow0 = 256 * (m.n0 >> 7) + 128 * kind + (m.n0 & 127);
    } else {
        m.W = A.in[20] + ((size_t)layer * NE + e) * DE * D; m.ldw = D;
        m.k0 = (q >> 5) * 64; m.n0 = (q & 31) * 32; m.WT = WSP(bf16_t, layer ? WS_DN1 : WS_DN) + (size_t)e * 1024 * 512; m.ldk = DE; m.drow0 = m.n0;
    }
    return m;
}
__device__ __forceinline__ void p0_prologue(const Frame& F, const Args& A) {
    LAS float* scr = (LAS float*)(F.lds + F.wave * 8448);
    const int gw = F.bid * 8 + F.wave, NGW = F.G * 8;
    const int gt = F.bid * 512 + F.tid, NT = F.G * 512;
    bf16_t* A0 = WSP(bf16_t, WS_RA);
    for (int p0 = gt; p0 < R * 128; p0 += 4 * NT) {
        f32x4 a[4], b[4];
#pragma unroll
        for (int u = 0; u < 4; ++u) { const int p = p0 + u * NT; const int r = p >> 7, c8 = (p & 127) * 8;
            const int rc = r < NTOK ? r : 0;
            const float* src = (rc < TREAL) ? (A.in[0] + (size_t)rc * D) : (A.in[1] + (size_t)(rc - TREAL) * D);
            a[u] = __builtin_nontemporal_load((const f32x4*)(src + c8)); b[u] = __builtin_nontemporal_load((const f32x4*)(src + c8 + 4)); }
#pragma unroll
        for (int u = 0; u < 4; ++u) { const int p = p0 + u * NT; const int r = p >> 7, c8 = (p & 127) * 8;
            u32x4 o; o.x = cvt_pk_bf16(a[u][0], a[u][1]); o.y = cvt_pk_bf16(a[u][2], a[u][3]); o.z = cvt_pk_bf16(b[u][0], b[u][1]); o.w = cvt_pk_bf16(b[u][2], b[u][3]);
            if (r >= NTOK) o = (u32x4){0u, 0u, 0u, 0u};
            if (r < R) *(u32x4*)(A0 + (size_t)r * D + c8) = o; }
    }
    if (F.bid == 0 && F.tid < 128) *(u32x4*)(WSP(bf16_t, WS_RC) + (size_t)(R - 1) * D + F.tid * 8) = (u32x4){0u, 0u, 0u, 0u};
    constexpr int I0 = 16 * 64;
    for (int it = gw; it < I0; it += NGW) transpose_dense_item<0>(A.in[2], D, 2048, WSP(bf16_t, WS_WIN0), it, scr, F.lane);
    bf16_t* wat = WSP(bf16_t, WS_WAT);
    for (int p = gt; p < 2 * 65536; p += NT) {
        const int which = p >> 16, q = p & 65535, hd = q >> 12, e = (q >> 6) & 63, d = q & 63;
        const float v = (which ? A.in[7] : A.in[5])[(hd * 64 + d) * 64 + e];
        wat[p] = (bf16_t)(cvt_pk_bf16(v, 0.f) & 0xffffu);
    }
    bf16_t* wrf = WSP(bf16_t, WS_WRF);
    for (int p = gt; p < 2 * 32 * 3 * 64 * 8; p += NT) {
        const int jj = p & 7, ln = (p >> 3) & 63, sb = (p >> 9) % 96, layer = p / (96 * 512), s = sb / 3, blk = sb % 3;
        const int n = blk * 16 + (ln & 15), k = 32 * s + 8 * (ln >> 4) + jj;
        float v = 0.f;
        if (n < 4) v = A.in[14][((size_t)layer * D + k) * NG + n];
        else if (n >= 16) v = A.in[16][((size_t)layer * D + k) * NE + (n - 16)];
        wrf[p] = (bf16_t)(cvt_pk_bf16(v, 0.f) & 0xffffu);
    }
}

constexpr int P2_WF = 0  , P2_CW = 16384  , P2_WV = 18432, P2_WVB = 8960  , P2_TR = 90112  ;
template <bool APPLY>
__device__ __forceinline__ void p2_lru(const Frame& F, const Args& A) {
    const bf16_t* xraw = WSP(bf16_t, WS_RC); const bf16_t* ybr = WSP(bf16_t, WS_RB); bf16_t* gout = WSP(bf16_t, WS_RA);
    float* scansum = WSP(float, WS_SCANSUM);
    LAS unsigned char* L = F.lds;
    LAS float* cwl = (LAS float*)(L + P2_CW);
    const int tid = F.tid, lane = F.lane, w = F.wave, fr = lane & 15, q = lane >> 4;
    LAS float* XCW = (LAS float*)(L + P2_WV + w * P2_WVB);
    LAS unsigned char* const YBW0 = L + P2_WV + w * P2_WVB + 4352;
    for (int u = F.bid; u < 256; u += F.G) {
        const int b = u >> 6, hd = (u >> 2) & 15, sg = u & 3, rho = sg * 8 + w;
        __syncthreads();
        { const bf16_t* wat = WSP(bf16_t, WS_WAT) + (size_t)hd * 4096;
          for (int p = tid; p < 1024; p += 512) { const int gate = p >> 9, n = (p >> 7) & 3, s2 = (p >> 6) & 1, ln = p & 63;
              *(LAS u32x4*)(L + P2_WF + p * 16) = *(const u32x4*)(wat + gate * 65536 + (16 * n + (ln & 15)) * 64 + 32 * s2 + 8 * (ln >> 4)); } }
        if (tid < 320) { const int k = tid >> 6, c = tid & 63; cwl[tid] = (k < 4) ? A.in[3][k * D + hd * 64 + c] : A.in[4][hd * 64 + c]; }
        float cba[4], cbi[4], csp[4];
#pragma unroll
        for (int n = 0; n < 4; ++n) { const int c = hd * 64 + 16 * n + fr; cba[n] = -1.44269504089f * A.in[6][c]; cbi[n] = -1.44269504089f * A.in[8][c];
            const float nl = -A.in[9][c]; csp[n] = -1.44269504089f * 8.0f * ((nl > 20.f) ? nl : log1pf(expf(nl))); }
        float hin[4] = {0.f, 0.f, 0.f, 0.f}, pin[4] = {1.f, 1.f, 1.f, 1.f};
        if (APPLY) {
#pragma unroll 1
            for (int r2 = 0; r2 < rho; ++r2) { const float* sp = scansum + (((size_t)(b * 16 + hd) * 32 + r2) * 64 + fr) * 2;
#pragma unroll
                for (int n = 0; n < 4; ++n) hin[n] = sp[n * 32] * hin[n] + sp[n * 32 + 1]; }
        }
        __syncthreads();
        const int nsc = (rho == 0) ? 17 : 16;
        const bf16_t* xbase = xraw + hd * 64 + 8 * q; const bf16_t* ybase = ybr + hd * 64 + (lane & 3) * 16;
        u32x4 xv[4][2], yv[2];
        f32x4 tv[8]; int tid_prev = -1;
        LAS float* trscr = (LAS float*)(L + P2_TR + w * 8448);
#define P2_LOAD(sc, XV, YV) do { const bool metac_ = (rho == 0 && (sc) == 0); const int P0_ = metac_ ? 0 : NMETA + rho * 256 + 16 * ((sc) - (rho == 0 ? 1 : 0)); \
            _Pragma("unroll") for (int k = 0; k < 4; ++k) { const int pos = P0_ + fr - 3 + k; \
                const size_t row = (pos < 0) ? (size_t)(R - 1)   : ((pos < NMETA) ? (size_t)(TREAL + pos) : ((size_t)b * SEQ + (pos - NMETA))); \
                XV[k][0] = *(const u32x4*)(xbase + row * D); XV[k][1] = *(const u32x4*)(xbase + row * D + 32); } \
            if (APPLY) { const int pos = P0_ + (lane >> 2); const size_t row = (pos < NMETA) ? (size_t)(TREAL + pos) : ((size_t)b * SEQ + (pos - NMETA)); \
                YV[0] = *(const u32x4*)(ybase + row * D); YV[1] = *(const u32x4*)(ybase + row * D + 8); } } while (0)
        P2_LOAD(0, xv, yv);
#define P2_GSTORE(sc, YB) do { const bool metac_ = (rho == 0 && (sc) == 0); if (!metac_ || b == 0) { \
            const int P0_ = metac_ ? 0 : NMETA + rho * 256 + 16 * ((sc) - (rho == 0 ? 1 : 0)); \
            const int pos = P0_ + (lane >> 2); const size_t row = (pos < NMETA) ? (size_t)(TREAL + pos) : ((size_t)b * SEQ + (pos - NMETA)); \
            bf16_t* gp = gout + row * D + hd * 64 + (lane & 3) * 16; \
            *(u32x4*)gp = *(const LAS u32x4*)((YB) + (lane >> 2) * 144 + ((lane & 3) * 2) * 16); \
            *(u32x4*)(gp + 8) = *(const LAS u32x4*)((YB) + (lane >> 2) * 144 + ((lane & 3) * 2 + 1) * 16); } } while (0)
#pragma unroll 1
        for (int sc = 0; sc < nsc; ++sc) {
            LAS unsigned char* const YBW = YBW0 + (sc & 1) * 2304;
            asm volatile("" ::: "memory");
            { const int idn = (APPLY ? 32768 : 0) + sc * 2048 + u * 8 + w; const int tid_next = (sc < 16 && idn < ALL_IDS) ? idn : -1;
              if (tid_prev >= 0) tr_to_lds(tv, trscr, lane);
              if (tid_next >= 0) { const MoeItem m = moe_item(F, A, tid_next); tr_issue(m.W, m.ldw, m.k0, m.n0, tv, lane); }
              if (tid_prev >= 0) { const MoeItem m = moe_item(F, A, tid_prev); tr_from_lds(m.WT, m.ldk, m.drow0, m.k0, trscr, lane); }
              tid_prev = tid_next; }
            bf16x8 af[2];
#pragma unroll
            for (int s2 = 0; s2 < 2; ++s2) {
                float xc[8];
                { const f32x4 ba = *(const LAS f32x4*)(cwl + 256 + 32 * s2 + 8 * q), bc = *(const LAS f32x4*)(cwl + 256 + 32 * s2 + 8 * q + 4);
#pragma unroll
                  for (int j = 0; j < 4; ++j) { xc[j] = ba[j]; xc[4 + j] = bc[j]; } }
#pragma unroll
                for (int k = 0; k < 4; ++k) { float xf[8]; unpack8(xv[k][s2], xf);
                    const f32x4 wa = *(const LAS f32x4*)(cwl + 64 * k + 32 * s2 + 8 * q), wb = *(const LAS f32x4*)(cwl + 64 * k + 32 * s2 + 8 * q + 4);
#pragma unroll
                    for (int j = 0; j < 4; ++j) { xc[j] += wa[j] * xf[j]; xc[4 + j] += wb[j] * xf[4 + j]; } }
                af[s2] = __builtin_bit_cast(bf16x8, pack8(xc));
                *(LAS f32x4*)(XCW + fr * 68 + 32 * s2 + 8 * q) = (f32x4){xc[0], xc[1], xc[2], xc[3]};
                *(LAS f32x4*)(XCW + fr * 68 + 32 * s2 + 8 * q + 4) = (f32x4){xc[4], xc[5], xc[6], xc[7]};
            }
            if (APPLY) { *(LAS u32x4*)(YBW + (lane >> 2) * 144 + ((lane & 3) * 2) * 16) = yv[0]; *(LAS u32x4*)(YBW + (lane >> 2) * 144 + ((lane & 3) * 2 + 1) * 16) = yv[1]; }
            LDS_WAIT(); asm volatile("" ::: "memory");
            if (sc + 1 < nsc) P2_LOAD(sc + 1, xv, yv);
            if (APPLY && sc > 0) P2_GSTORE(sc - 1, YBW0 + ((sc - 1) & 1) * 2304);
            asm volatile("" ::: "memory");
            float xcv[4][4], ybv[4][4];
#pragma unroll
            for (int n = 0; n < 4; ++n)
#pragma unroll
                for (int j = 0; j < 4; ++j) { xcv[n][j] = XCW[(4 * q + j) * 68 + 16 * n + fr];
                    if (APPLY) ybv[n][j] = bf1(*((const LAS unsigned short*)(YBW + (4 * q + j) * 144) + 16 * n + fr)); }
            float av[4][4], bv[4][4], Ap[4], Bp[4];
#pragma unroll
            for (int n = 0; n < 4; ++n) {
                f32x4 ca = (f32x4){0.f, 0.f, 0.f, 0.f}, ci = ca;
#pragma unroll
                for (int s2 = 0; s2 < 2; ++s2) { const bf16x8 fa = *(const LAS bf16x8*)(L + P2_WF + (((0 * 4 + n) * 2 + s2) * 64 + lane) * 16), fi = *(const LAS bf16x8*)(L + P2_WF + (((1 * 4 + n) * 2 + s2) * 64 + lane) * 16);
                    ca = __builtin_amdgcn_mfma_f32_16x16x32_bf16(af[s2], fa, ca, 0, 0, 0); ci = __builtin_amdgcn_mfma_f32_16x16x32_bf16(af[s2], fi, ci, 0, 0, 0); }
                Ap[n] = 1.f; Bp[n] = 0.f;
#pragma unroll
                for (int j = 0; j < 4; ++j) {
                    const float r = __builtin_amdgcn_rcpf(1.0f + __builtin_amdgcn_exp2f(__builtin_fmaf(ca[j], -1.44269504089f, cba[n])));
                    const float gi = __builtin_amdgcn_rcpf(1.0f + __builtin_amdgcn_exp2f(__builtin_fmaf(ci[j], -1.44269504089f, cbi[n])));
                    const float a = __builtin_amdgcn_exp2f(csp[n] * r);
                    const float om = __builtin_fmaf(-a, a, 1.0f);
                    av[n][j] = a; bv[n][j] = __builtin_sqrtf(om) * gi * xcv[n][j];
                    Bp[n] = a * Bp[n] + bv[n][j]; Ap[n] *= a;
                }
            }
            float Aq[4][4], Bq[4][4];
#pragma unroll
            for (int n = 0; n < 4; ++n)
#pragma unroll
                for (int q2 = 0; q2 < 4; ++q2) { Aq[n][q2] = __shfl(Ap[n], fr + 16 * q2); Bq[n][q2] = __shfl(Bp[n], fr + 16 * q2); }
#pragma unroll
            for (int n = 0; n < 4; ++n) {
                float h = hin[n];
#pragma unroll
                for (int q2 = 0; q2 < 3; ++q2) { const float hq = Aq[n][q2] * h + Bq[n][q2]; h = (q2 < q) ? hq : h; }
                if (APPLY) {
#pragma unroll
                    for (int j = 0; j < 4; ++j) { h = av[n][j] * h + bv[n][j]; ybv[n][j] *= h; }
                }
                float he = hin[n];
#pragma unroll
                for (int q2 = 0; q2 < 4; ++q2) he = Aq[n][q2] * he + Bq[n][q2];
                hin[n] = he; pin[n] *= (Aq[n][0] * Aq[n][1]) * (Aq[n][2] * Aq[n][3]);
            }
            if (APPLY) {
#pragma unroll
                for (int n = 0; n < 4; ++n)
#pragma unroll
                    for (int j = 0; j < 4; ++j) *((LAS unsigned short*)(YBW + (4 * q + j) * 144) + 16 * n + fr) = (unsigned short)(cvt_pk_bf16(ybv[n][j], 0.f) & 0xffffu);
            }
            LDS_WAIT(); asm volatile("" ::: "memory");
        }
        if (APPLY) P2_GSTORE(nsc - 1, YBW0 + ((nsc - 1) & 1) * 2304);
        if (tid_prev >= 0) { const MoeItem m = moe_item(F, A, tid_prev); tr_finish(tv, m.WT, m.ldk, m.drow0, m.k0, trscr, lane); }
#undef P2_GSTORE
#undef P2_LOAD
        if (!APPLY && q == 0) { float* sp = scansum + (((size_t)(b * 16 + hd) * 32 + rho) * 64 + fr) * 2;
#pragma unroll
            for (int n = 0; n < 4; ++n) { sp[n * 32] = pin[n]; sp[n * 32 + 1] = hin[n]; } }
    }
}
constexpr int P4_WRF = 0, P4_LNG = 98304, P4_LNB = 102400, P4_LG = 106496  , P4_HIST = SMALL_OFF, P4_BASE = SMALL_OFF + 256;
__device__ __forceinline__ void p4_ln_route(const Frame& F, const Args& A, int layer, const bf16_t* y1, bf16_t* h1) {
    LAS unsigned char* L = F.lds;
    const int tid = F.tid, lane = F.lane, w = F.wave;
    const f32x2* stats = WSP(const f32x2, WS_STATS);
    int* list = WSP(int, WS_LIST); float* tokgate = WSP(float, WS_TOKGATE);
    unsigned* cnt = WSP(unsigned, WS_CTL) + CW_CNT + 64 * layer;
    const float* lng = A.in[21] + (size_t)(layer * 2 + 0) * D; const float* lnb = A.in[22] + (size_t)(layer * 2 + 0) * D;
    const float* bgrp = A.in[15] + layer * NG; const float* bexp = A.in[17] + layer * NE;
    const int gw = F.bid * 8 + w, NGW = F.G * 8;
    constexpr int NGR = TREAL / 16;
    const int fr = lane & 15, q = lane >> 4;
    f32x4 pa0 = (f32x4){0.f, 0.f, 0.f, 0.f}, pb0 = pa0; u32x4 ypre[8];
    { const int tok0 = (gw < NGR ? gw : 0) * 16 + fr;
      pa0 = *(const f32x4*)(stats + (size_t)tok0 * 16 + 4 * q); pb0 = *(const f32x4*)(stats + (size_t)tok0 * 16 + 4 * q + 2);
#pragma unroll
      for (int s2 = 0; s2 < 8; ++s2) ypre[s2] = *(const u32x4*)(y1 + (size_t)tok0 * D + 8 * q + 32 * s2); }
    __syncthreads();
    { const u32x4* src = (const u32x4*)(WSP(bf16_t, WS_WRF) + (size_t)layer * 49152);
      for (int p = tid; p < 6144; p += 512) *(LAS u32x4*)(L + P4_WRF + p * 16) = src[p];
      for (int p = tid; p < 256; p += 512) { *(LAS f32x4*)(L + P4_LNG + p * 16) = ((const f32x4*)lng)[p]; *(LAS f32x4*)(L + P4_LNB + p * 16) = ((const f32x4*)lnb)[p]; } }
    for (int p = F.bid * 512 + tid; p < (R - NTOK) * 128; p += F.G * 512) *(u32x4*)(h1 + (size_t)(NTOK + (p >> 7)) * D + (p & 127) * 8) = (u32x4){0u, 0u, 0u, 0u};
    LAS int* hist = (LAS int*)(L + P4_HIST); LAS int* basep = (LAS int*)(L + P4_BASE);
    LAS float* LG = (LAS float*)(L + P4_LG + w * 2048);
    const int niter = (NGR + NGW - 1) / NGW;
#pragma unroll 1
    for (int it = 0; it < niter; ++it) {
        __syncthreads();
        if (tid < 32) hist[tid] = 0;
        __syncthreads();
        int e0[2] = {0, 0}, e1[2] = {0, 0}, r0[2] = {0, 0}, r1[2] = {0, 0}; float g0[2] = {0.f, 0.f}, g1[2] = {0.f, 0.f}; int tokv[2] = {0, 0}; bool act[2] = {false, false};
#pragma unroll
        for (int gi = 0; gi < 2; ++gi) {
            const int grp = (gi == 0) ? (it * NGW + gw) : NGR;
            const bool active = (gi == 0) ? (grp < NGR) : (layer == 0 && it == 0 && gw == 0);
            act[gi] = active;
            const int tok = grp * 16 + fr; tokv[gi] = tok;
            if (active) {
                const bool first = (gi == 0 && it == 0);
                f32x4 pa = pa0, pb = pb0;
                if (!first) { pa = *(const f32x4*)(stats + (size_t)tok * 16 + 4 * q); pb = *(const f32x4*)(stats + (size_t)tok * 16 + 4 * q + 2); }
                float s1 = (pa[0] + pa[2]) + (pb[0] + pb[2]), s2 = (pa[1] + pa[3]) + (pb[1] + pb[3]);
                s1 += __shfl_xor(s1, 16); s1 += __shfl_xor(s1, 32); s2 += __shfl_xor(s2, 16); s2 += __shfl_xor(s2, 32);
                const float mu = s1 * (1.f / D), var = fmaxf(s2 * (1.f / D) - mu * mu, 0.f), rstd = __builtin_amdgcn_rsqf(var + LN_EPS);
                f32x4 acc[3];
#pragma unroll
                for (int k = 0; k < 3; ++k) acc[k] = (f32x4){0.f, 0.f, 0.f, 0.f};
                const bf16_t* yrow = y1 + (size_t)tok * D + 8 * q; bf16_t* hrow = h1 + (size_t)tok * D + 8 * q;
#pragma unroll 1
                for (int half = 0; half < 4; ++half) {
                    u32x4 yb[8];
                    if (half == 0 && first) {
#pragma unroll
                        for (int s2 = 0; s2 < 8; ++s2) yb[s2] = ypre[s2];
                    } else {
#pragma unroll
                        for (int s2 = 0; s2 < 8; ++s2) yb[s2] = *(const u32x4*)(yrow + 32 * (8 * half + s2));
                    }
#pragma unroll
                    for (int s2 = 0; s2 < 8; ++s2) {
                        const int s = 8 * half + s2;
                        float y[8], g[8], bb[8], h[8];
                        unpack8(yb[s2], y);
                        const int k0 = 32 * s + 8 * q;
                        { const f32x4 ga = *(const LAS f32x4*)(L + P4_LNG + k0 * 4), gb = *(const LAS f32x4*)(L + P4_LNG + k0 * 4 + 16);
                          const f32x4 ba = *(const LAS f32x4*)(L + P4_LNB + k0 * 4), bc = *(const LAS f32x4*)(L + P4_LNB + k0 * 4 + 16);
#pragma unroll
                          for (int j = 0; j < 4; ++j) { g[j] = ga[j]; g[4 + j] = gb[j]; bb[j] = ba[j]; bb[4 + j] = bc[j]; } }
#pragma unroll
                        for (int j = 0; j < 8; ++j) h[j] = (y[j] - mu) * rstd * g[j] + bb[j];
                        const u32x4 hw = pack8(h);
                        *(u32x4*)(hrow + 32 * s) = hw;
                        const bf16x8 hb = __builtin_bit_cast(bf16x8, hw);
#pragma unroll
                        for (int blk = 0; blk < 3; ++blk) { const bf16x8 wf = *(const LAS bf16x8*)(L + P4_WRF + ((s * 3 + blk) * 64 + lane) * 16);
                            acc[blk] = __builtin_amdgcn_mfma_f32_16x16x32_bf16(wf, hb, acc[blk], 0, 0, 0); }
                    }
                }
#pragma unroll
                for (int j = 0; j < 4; ++j) { LG[fr * 32 + 4 * q + j] = acc[1][j]; LG[fr * 32 + 16 + 4 * q + j] = acc[2][j]; }
                LDS_WAIT(); asm volatile("" ::: "memory");
                if (q == 0) {
                    float gl[4]; int g = 0; float gm = -3.4e38f;
#pragma unroll
                    for (int j = 0; j < 4; ++j) { gl[j] = acc[0][j] + bgrp[j]; if (gl[j] > gm) { gm = gl[j]; g = j; } }
                    float se = 0.f;
#pragma unroll
                    for (int j = 0; j < 4; ++j) se += __expf(gl[j] - gm);
                    const float pg = 1.f / se;
                    const f32x4 la = *(const LAS f32x4*)(LG + fr * 32 + 8 * g), lb = *(const LAS f32x4*)(LG + fr * 32 + 8 * g + 4);
                    const f32x4 ba = *(const f32x4*)(bexp + 8 * g), bc = *(const f32x4*)(bexp + 8 * g + 4);
                    float el[8];
#pragma unroll
                    for (int j = 0; j < 4; ++j) { el[j] = la[j] + ba[j]; el[4 + j] = lb[j] + bc[j]; }
                    int i0 = -1, i1 = -1; float v0 = -3.4e38f, v1 = -3.4e38f;
#pragma unroll
                    for (int j = 0; j < 8; ++j) { const float v = el[j];
                        if (v > v0) { v1 = v0; i1 = i0; v0 = v; i0 = j; } else if (v > v1) { v1 = v; i1 = j; } }
                    const float ex = __expf(v1 - v0);
                    const float p0 = 1.f / (1.f + ex);
                    g0[gi] = pg * p0; g1[gi] = pg * (ex * p0);
                    e0[gi] = g * 8 + i0; e1[gi] = g * 8 + i1;
                    r0[gi] = __hip_atomic_fetch_add(&hist[e0[gi]], 1, __ATOMIC_RELAXED, __HIP_MEMORY_SCOPE_WORKGROUP); r1[gi] = __hip_atomic_fetch_add(&hist[e1[gi]], 1, __ATOMIC_RELAXED, __HIP_MEMORY_SCOPE_WORKGROUP);
                }
                LDS_WAIT(); asm volatile("" ::: "memory");
            }
        }
        __syncthreads();
        if (tid < 32) { const int hcnt = hist[tid]; basep[tid] = hcnt ? (int)__hip_atomic_fetch_add(cnt + tid, (unsigned)hcnt, RLX_AGENT) : 0; }
        __syncthreads();
#pragma unroll
        for (int gi = 0; gi < 2; ++gi) if (act[gi] && q == 0) {
            const int p0 = basep[e0[gi]] + r0[gi], p1 = basep[e1[gi]] + r1[gi];
            list[e0[gi] * CAP + p0] = 2 * tokv[gi]; list[e1[gi] * CAP + p1] = 2 * tokv[gi] + 1;
            tokgate[2 * tokv[gi]] = g0[gi]; tokgate[2 * tokv[gi] + 1] = g1[gi];
        }
    }
}

__device__ __forceinline__ int moe_tables(const Frame& F, int layer) {
    LAS int* tbl = (LAS int*)(F.lds + SMALL_OFF + 1024);
    const unsigned* cnt = WSP(const unsigned, WS_CTL) + CW_CNT + 64 * layer;
    __syncthreads();
    if (F.tid < 32) tbl[F.tid] = (int)__hip_atomic_load(cnt + F.tid, RLX_AGENT);
    __syncthreads();
    if (F.tid == 0) { int s = 0; for (int e = 0; e < NE; ++e) { tbl[32 + e] = s; s += (tbl[e] + 255) >> 8; } tbl[64] = s; }
    __syncthreads();
    return 4 * tbl[64];
}

template <bool FINAL>
__device__ __forceinline__ void p7_combine(const Frame& F, const Args& A, int layer, const bf16_t* h1, const bf16_t* cbuf, bf16_t* h2, float* out) {
    const int lane = F.lane, gw = F.bid * 8 + F.wave, NGW = F.G * 8;
    const float* lng = A.in[21] + (size_t)(layer * 2 + 1) * D; const float* lnb = A.in[22] + (size_t)(layer * 2 + 1) * D;
    float g[16], bb[16];
#pragma unroll
    for (int hx = 0; hx < 2; ++hx) { const int c0 = hx * 512 + lane * 8;
        const f32x4 ga = *(const f32x4*)(lng + c0), gb = *(const f32x4*)(lng + c0 + 4), ba = *(const f32x4*)(lnb + c0), bc = *(const f32x4*)(lnb + c0 + 4);
#pragma unroll
        for (int j = 0; j < 4; ++j) { g[hx * 8 + j] = ga[j]; g[hx * 8 + 4 + j] = gb[j]; bb[hx * 8 + j] = ba[j]; bb[hx * 8 + 4 + j] = bc[j]; } }
    const int ntok = FINAL ? TREAL : NTOK;
#pragma unroll 2
    for (int t = gw; t < ntok; t += NGW) {
        float y[16];
#pragma unroll
        for (int hx = 0; hx < 2; ++hx) { const int c0 = hx * 512 + lane * 8;
            float a[8], c0v[8], c1v[8];
            unpack8(*(const u32x4*)(h1 + (size_t)t * D + c0), a);
            unpack8(*(const u32x4*)(cbuf + (size_t)(2 * t) * D + c0), c0v);
            unpack8(*(const u32x4*)(cbuf + (size_t)(2 * t + 1) * D + c0), c1v);
#pragma unroll
            for (int j = 0; j < 8; ++j) y[hx * 8 + j] = ALPHA * a[j] + (c0v[j] + c1v[j]); }
        float s = 0.f;
#pragma unroll
        for (int j = 0; j < 16; ++j) s += y[j];
        const float mu = wave_sum(s) * (1.f / D);
        float qv = 0.f;
#pragma unroll
        for (int j = 0; j < 16; ++j) { y[j] -= mu; qv += y[j] * y[j]; }
        const float rstd = __builtin_amdgcn_rsqf(wave_sum(qv) * (1.f / D) + LN_EPS);
#pragma unroll
        for (int j = 0; j < 16; ++j) y[j] = y[j] * rstd * g[j] + bb[j];
#pragma unroll
        for (int hx = 0; hx < 2; ++hx) { const int c0 = hx * 512 + lane * 8;
            if (FINAL) { *(f32x4*)(out + (size_t)t * D + c0) = (f32x4){y[hx * 8 + 0], y[hx * 8 + 1], y[hx * 8 + 2], y[hx * 8 + 3]};
                         *(f32x4*)(out + (size_t)t * D + c0 + 4) = (f32x4){y[hx * 8 + 4], y[hx * 8 + 5], y[hx * 8 + 6], y[hx * 8 + 7]}; }
            else { float o[8];
#pragma unroll
                for (int j = 0; j < 8; ++j) o[j] = y[hx * 8 + j];
                *(u32x4*)(h2 + (size_t)t * D + c0) = pack8(o); } }
    }
}

__device__ __forceinline__ void p9_convgate(const Frame& F, const Args& A, const bf16_t* bg, const bf16_t* z, bf16_t* g1) {
    const float* cw = A.in[12];
    const int gt = F.bid * 512 + F.tid, NT = F.G * 512;
    for (int item = gt; item < (TREAL / 16) * 128; item += NT) {
        const int pc = item & 127, run = item >> 7, r0 = run * 16, c0 = pc * 8;
        float w0[8], w1[8], w2[8];
        { const f32x4 a = *(const f32x4*)(cw + c0), b = *(const f32x4*)(cw + c0 + 4), c = *(const f32x4*)(cw + D + c0), d = *(const f32x4*)(cw + D + c0 + 4), e = *(const f32x4*)(cw + 2 * D + c0), f = *(const f32x4*)(cw + 2 * D + c0 + 4);
#pragma unroll
          for (int j = 0; j < 4; ++j) { w0[j] = a[j]; w0[4 + j] = b[j]; w1[j] = c[j]; w1[4 + j] = d[j]; w2[j] = e[j]; w2[4 + j] = f[j]; } }
        const bool first = (r0 & (SEQ - 1)) == 0;
        const size_t rm1 = first ? (size_t)(TREAL + NMETA - 1) : (size_t)(r0 - 1), rm2 = first ? (size_t)(TREAL + NMETA - 2) : (size_t)(r0 - 2);
        float z1[8], z2[8];
        unpack8(*(const u32x4*)(z + rm1 * D + c0), z1); unpack8(*(const u32x4*)(z + rm2 * D + c0), z2);
#pragma unroll 4
        for (int j = 0; j < 16; ++j) {
            float z0[8], b[8], o[8];
            unpack8(*(const u32x4*)(z + (size_t)(r0 + j) * D + c0), z0); unpack8(*(const u32x4*)(bg + (size_t)(r0 + j) * D + c0), b);
#pragma unroll
            for (int i = 0; i < 8; ++i) { o[i] = b[i] * (w0[i] * z2[i] + w1[i] * z1[i] + w2[i] * z0[i]); z2[i] = z1[i]; z1[i] = z0[i]; }
            *(u32x4*)(g1 + (size_t)(r0 + j) * D + c0) = pack8(o);
        }
    }
}

template <int NT> __device__ __forceinline__ void meta_partials(const Frame& F, const bf16_t* a16, const bf16_t* wt, const int (&n0)[NT]) {
    const int lane = F.lane, fr = lane & 15, q = lane >> 4, w = F.wave;
    const bf16_t* ap = a16 + (size_t)fr * D + 8 * q + 128 * w;
    bf16x8 af[4], bfr[NT][4];
#pragma unroll
    for (int s = 0; s < 4; ++s) af[s] = *(const bf16x8*)(ap + 32 * s);
#pragma unroll
    for (int t = 0; t < NT; ++t) { const bf16_t* bp = wt + (size_t)(n0[t] + fr) * D + 8 * q + 128 * w;
#pragma unroll
        for (int s = 0; s < 4; ++s) bfr[t][s] = *(const bf16x8*)(bp + 32 * s); }
#pragma unroll
    for (int t = 0; t < NT; ++t) { f32x4 acc = (f32x4){0.f, 0.f, 0.f, 0.f};
#pragma unroll
        for (int s = 0; s < 4; ++s) acc = __builtin_amdgcn_mfma_f32_16x16x32_bf16(af[s], bfr[t][s], acc, 0, 0, 0);
        *(LAS f32x4*)(F.lds + ((w * NT + t) * 64 + lane) * 16) = acc; }
    __syncthreads();
}
template <int NT> __device__ __forceinline__ f32x4 meta_reduce(const Frame& F, int t) {
    f32x4 acc = (f32x4){0.f, 0.f, 0.f, 0.f};
#pragma unroll
    for (int w = 0; w < 8; ++w) acc += *(const LAS f32x4*)(F.lds + ((w * NT + t) * 64 + F.lane) * 16);
    return acc;
}
__device__ __forceinline__ bf16_t bf16_of(float v) { return (bf16_t)(cvt_pk_bf16(v, 0.f) & 0xffffu); }
__device__ __forceinline__ void meta_in0(const Frame& F) {
    const int g = F.bid; if (g >= 32) return;
    const int lane = F.lane, fr = lane & 15, q = lane >> 4;
    const int n0[4] = {g * 64, g * 64 + 16, g * 64 + 32, g * 64 + 48};
    __syncthreads();
    meta_partials<4>(F, WSP(const bf16_t, WS_RA) + (size_t)TREAL * D, WSP(const bf16_t, WS_WIN0), n0);
    if (F.wave < 4) { const int t = F.wave; const f32x4 acc = meta_reduce<4>(F, t);
        const bool left = g < 16; bf16_t* base = left ? WSP(bf16_t, WS_RB) : WSP(bf16_t, WS_RC);
#pragma unroll
        for (int j = 0; j < 4; ++j) { const float v = left ? gelu_tanh_f(acc[j]) : acc[j]; base[(size_t)(TREAL + 4 * q + j) * D + (((g * 64) & 1023) + 16 * t + fr)] = bf16_of(v); } }
    __syncthreads();
}
__device__ __forceinline__ void meta_out0(const Frame& F, const Args& A) {
    const int g = F.bid; if (g >= 16) return;
    const int lane = F.lane, fr = lane & 15, q = lane >> 4;
    const int n0[4] = {g * 64, g * 64 + 16, g * 64 + 32, g * 64 + 48};
    __syncthreads();
    meta_partials<4>(F, WSP(const bf16_t, WS_RA) + (size_t)TREAL * D, WSP(const bf16_t, WS_WOUT0), n0);
    LAS float* sp = (LAS float*)(F.lds + 65536);
    if (F.wave < 4) { const int t = F.wave; const f32x4 acc = meta_reduce<4>(F, t);
        bf16_t* y1 = WSP(bf16_t, WS_RB);
#pragma unroll
        for (int j = 0; j < 4; ++j) { const int m = 4 * q + j; const int col = g * 64 + 16 * t + fr;
            const float v = acc[j] + ALPHA * A.in[1][(size_t)m * D + col]; float s1 = v, s2 = v * v;
            y1[(size_t)(TREAL + m) * D + col] = bf16_of(v);
#pragma unroll
            for (int o = 1; o < 16; o <<= 1) { s1 += __shfl_xor(s1, o); s2 += __shfl_xor(s2, o); }
            if (fr == 0) { sp[(t * 16 + m) * 2] = s1; sp[(t * 16 + m) * 2 + 1] = s2; } } }
    __syncthreads();
    if (F.tid < 16) { const int m = F.tid; float s1 = 0.f, s2 = 0.f;
#pragma unroll
        for (int t = 0; t < 4; ++t) { s1 += sp[(t * 16 + m) * 2]; s2 += sp[(t * 16 + m) * 2 + 1]; }
        WSP(f32x2, WS_STATS)[(size_t)(TREAL + m) * 16 + g] = (f32x2){s1, s2}; }
    __syncthreads();
}
__device__ __forceinline__ void meta_in1(const Frame& F) {
    const int g = F.bid; if (g >= 16) return;
    const int lane = F.lane, fr = lane & 15, q = lane >> 4;
    const int zc0 = g * 64;
    const int r0 = 1024 + 256 * (zc0 >> 7) + (zc0 & 127);
    const int n0[8] = {r0, r0 + 16, r0 + 32, r0 + 48, r0 + 128, r0 + 144, r0 + 160, r0 + 176};
    __syncthreads();
    meta_partials<8>(F, WSP(const bf16_t, WS_RA) + (size_t)TREAL * D, WSP(const bf16_t, WS_WIN1), n0);
    if (F.wave < 4) { const int t = F.wave; const f32x4 cg = meta_reduce<8>(F, t), vv = meta_reduce<8>(F, 4 + t);
        bf16_t* z = WSP(bf16_t, WS_RC);
#pragma unroll
        for (int j = 0; j < 4; ++j) z[(size_t)(TREAL + 4 * q + j) * D + zc0 + 16 * t + fr] = bf16_of(cg[j] * vv[j]); }
    __syncthreads();
}
#define XB_TMO      128
#define XB_XCNT(j)  (256  + 64 * (j))
#define XB_XSUB(j)  (1280 + 64 * (j))
#define XB_XGEN(j)  (2304 + 64 * (j))
#define XB_TOP      3328
#define XB_TOPGEN   3392
#define XCD_BAR_WORDS 3456
#define XB_SPIN_CAP (1u << 20)
__device__ __forceinline__ unsigned xb_ld(unsigned* p)              { return __hip_atomic_load(p, __ATOMIC_RELAXED, __HIP_MEMORY_SCOPE_AGENT); }
__device__ __forceinline__ unsigned xb_add(unsigned* p, unsigned v) { return __hip_atomic_fetch_add(p, v, __ATOMIC_RELAXED, __HIP_MEMORY_SCOPE_AGENT); }
__device__ __forceinline__ unsigned xb_xcc_id() { return (unsigned)__builtin_amdgcn_s_getreg((3 << 11) | 20) & 0xFu; }
#define XB_SPIN(cond, bar) do { unsigned _sp = 0; while (cond) { __builtin_amdgcn_s_sleep(1); \
    if ((++_sp & 255u) == 0u) { if (xb_ld(&(bar)[XB_TMO])) break; if (_sp > XB_SPIN_CAP) { atomicAdd(&(bar)[XB_TMO], 1u); break; } } } } while (0)
struct XcdBarrier { unsigned* bar; unsigned x; volatile LAS unsigned* st; };
__device__ __forceinline__ XcdBarrier xcd_barrier_post(unsigned* bar, volatile LAS unsigned* st) {
    XcdBarrier b; b.bar = bar; b.x = xb_xcc_id(); b.st = st;
    if (threadIdx.x == 0) (void)xb_add(&bar[XB_XCNT(b.x)], 1u);
    return b;
}
__device__ __forceinline__ void xcd_barrier_complete(unsigned* bar, unsigned x, unsigned& nloc, unsigned& nx) {
    const unsigned G = gridDim.x * gridDim.y * gridDim.z;
    unsigned sum, cnt, mine, sp = 0u;
    for (;;) {
        sum = 0u; cnt = 0u; mine = 0u;
#pragma unroll
        for (unsigned j = 0; j < 16; ++j) { const unsigned c = xb_ld(&bar[XB_XCNT(j)]); sum += c; cnt += (c > 0u) ? 1u : 0u; mine = (j == x) ? c : mine; }
        if (sum == G) break;
        __builtin_amdgcn_s_sleep(1);
        if ((++sp & 255u) == 0u) { if (xb_ld(&bar[XB_TMO])) break; if (sp > XB_SPIN_CAP) { atomicAdd(&bar[XB_TMO], 1u); break; } }
    }
    nloc = mine > 0u ? mine : 1u; nx = cnt > 0u ? cnt : 1u;
}
__device__ __forceinline__ void xcd_barrier(const XcdBarrier& b) {
    asm volatile("s_waitcnt vmcnt(0)" ::: "memory");
    __syncthreads();
    if (threadIdx.x == 0) {
        unsigned* bar = b.bar;
        __builtin_amdgcn_s_waitcnt(0);
        unsigned nloc = b.st[0], nx = b.st[1];
        if (nloc == 0u) { xcd_barrier_complete(bar, b.x, nloc, nx); b.st[0] = nloc; b.st[1] = nx; }
        const unsigned old = xb_add(&bar[XB_XSUB(b.x)], 1u);
        const unsigned gen = old / nloc;
        if (old + 1u == (gen + 1u) * nloc) {
            __builtin_amdgcn_fence(__ATOMIC_RELEASE, "agent");
            asm volatile("s_waitcnt vmcnt(0)" ::: "memory");
            const unsigned og = xb_add(&bar[XB_TOP], 1u);
            const unsigned tg = og / nx;
            if (og + 1u == (tg + 1u) * nx) xb_add(&bar[XB_TOPGEN], 1u);
            else XB_SPIN(xb_ld(&bar[XB_TOPGEN]) == tg, bar);
            __builtin_amdgcn_fence(__ATOMIC_ACQUIRE, "agent");
            xb_add(&bar[XB_XGEN(b.x)], 1u);
            asm volatile("s_waitcnt vmcnt(0)" ::: "memory");
        } else {
            XB_SPIN(xb_ld(&bar[XB_XGEN(b.x)]) == gen, bar);
            __builtin_amdgcn_fence(__ATOMIC_ACQUIRE, "agent");
            asm volatile("s_waitcnt vmcnt(0)" ::: "memory");
        }
    }
    __syncthreads();
}

constexpr int DBG_NS = 4096, DBG_SLOTS = 16;
__host__ __device__ __forceinline__ void dbg_rc(int i, int nrows, int& r, int& c) {
    const unsigned h = (unsigned)i * 2654435761u;
    c = (int)((h >> 9) & 1023u);
    if (i < 64) { const int sp[8] = {0, 1, 2, 8192, 8193, 32768, 32783, 32767}; r = sp[i & 7] % nrows; }
    else r = (int)(((unsigned)i * 40503u + (h >> 20)) % (unsigned)nrows);
}
__device__ __forceinline__ void dbg_sample_bf16(const Frame& F, int slot, const bf16_t* buf, int nrows) {
    float* dg = (float*)(F.ws + WS_DIGEST) + (size_t)slot * DBG_NS;
    for (int i = F.bid * 512 + F.tid; i < DBG_NS; i += F.G * 512) { int r, c; dbg_rc(i, nrows, r, c); dg[i] = bf1(buf[(size_t)r * D + c]); }
}
__device__ __forceinline__ void dbg_sample_c(const Frame& F, int slot, const bf16_t* cbuf) {
    float* dg = (float*)(F.ws + WS_DIGEST) + (size_t)slot * DBG_NS;
    for (int i = F.bid * 512 + F.tid; i < DBG_NS; i += F.G * 512) { int r, c; dbg_rc(i, NTOK, r, c); dg[i] = bf1(cbuf[(size_t)(2 * r + (i & 1)) * D + c]); }
}
__device__ __forceinline__ void dbg_sample_gate(const Frame& F, int slot) {
    float* dg = (float*)(F.ws + WS_DIGEST) + (size_t)slot * DBG_NS; const float* tg = (const float*)(F.ws + WS_TOKGATE);
    for (int i = F.bid * 512 + F.tid; i < DBG_NS; i += F.G * 512) { int r, c; dbg_rc(i, NTOK, r, c); dg[i] = tg[2 * r + (i & 1)]; }
}

#ifndef MK_SKEW_NS
#define MK_SKEW_NS 0
#endif
__device__ __forceinline__ void gemm_skew(const Frame& F) {
    if (MK_SKEW_NS > 0) { const unsigned long long t0 = __builtin_amdgcn_s_memrealtime(); const unsigned long long d = (unsigned long long)((F.bid >> 6) & 3) * (MK_SKEW_NS / 10);
        while (__builtin_amdgcn_s_memrealtime() - t0 < d) __builtin_amdgcn_s_sleep(4); }
}
__global__ void __launch_bounds__(512, 2) mk_fwd(Args args) {
    extern __shared__ __attribute__((aligned(16))) unsigned char lds_raw[];
    Frame F;
    F.lds = (LAS unsigned char*)lds_raw;
    F.tid = threadIdx.x; F.lane = F.tid & 63; F.wave = __builtin_amdgcn_readfirstlane(F.tid >> 6);
    F.G = gridDim.x; F.bid = blockIdx.x;
    F.ws = args.ws;
    volatile LAS unsigned* MISC = (volatile LAS unsigned*)(F.lds + MISC_OFF);
    if (F.tid < 64) MISC[F.tid] = 0u;
    __syncthreads();
    XcdBarrier bar; bar.bar = (unsigned*)(F.ws + WS_CTL) + CW_BAR; bar.x = 0; bar.st = nullptr;
    if (MK_N_LAUNCHES == 1) bar = xcd_barrier_post((unsigned*)(F.ws + WS_CTL) + CW_BAR, MISC + 8);
    const int lo = args.ph_lo, hi = args.ph_hi;
#ifndef MK_TIME_PHASE
#define MK_TIME_PHASE -1
#endif
    volatile LAS unsigned long long* STAMP = (volatile LAS unsigned long long*)(F.lds + MISC_OFF + 1024);
#define STAMP_AT(k) do { if (MK_TIME_PHASE >= 0 && F.bid == 0 && F.tid == 0) STAMP[k] = __builtin_amdgcn_s_memrealtime(); } while (0)
    STAMP_AT(0);
#define IN(k) (lo <= (k) && (k) < hi)
#ifndef MK_EXTRA_BAR
#define MK_EXTRA_BAR 0
#endif
#define SEAM(k) do { if (IN(k) && IN((k) + 1)) { for (int xb_ = 0; xb_ <= MK_EXTRA_BAR; ++xb_) xcd_barrier(bar); } STAMP_AT((k) + 1); } while (0)
#ifndef MK_REP_MASK
#define MK_REP_MASK 0
#endif
#define REPS(k) for (int rep_ = 0; rep_ < 1 + ((MK_REP_MASK >> (k)) & 1); ++rep_, (void)((rep_ < 1 + ((MK_REP_MASK >> (k)) & 1)) ? (xcd_barrier(bar), 0) : 0))
    bf16_t* RA = WSP(bf16_t, WS_RA); bf16_t* RBb = WSP(bf16_t, WS_RB); bf16_t* RC = WSP(bf16_t, WS_RC); bf16_t* RE = WSP(bf16_t, WS_RE);
    LAS int* tbl = (LAS int*)(F.lds + SMALL_OFF + 1024);

    if (IN(0)) REPS(0) { p0_prologue(F, args); } SEAM(0);
    if (IN(1)) REPS(1) {
        meta_in0(F);
        ProbIn0 P; P.Abase = (const char*)RA; P.ord.init(TREAL / 256, 8, F.G, F.bid); P.Bt = (const char*)(F.ws + WS_WIN0); P.ybr = RBb; P.xraw = RC;
        gemm_skew(F); pg8::gemm_phase(F.lds, P);
    } SEAM(1);
    if (IN(2)) REPS(2) { if (MK_DEBUG_ORACLE) { dbg_sample_bf16(F, 0, RBb, NTOK); dbg_sample_bf16(F, 1, RC, NTOK); } p2_lru<false>(F, args); } SEAM(2);
    if (IN(3)) REPS(3) { p2_lru<true>(F, args); } SEAM(3);
    if (IN(4)) REPS(4) {
        if (MK_DEBUG_ORACLE) dbg_sample_bf16(F, 2, RA, NTOK);
        meta_out0(F, args);
        ProbOut<true> P; P.Abase = (const char*)RA; P.ord.init(TREAL / 256, 4, F.G, F.bid); P.Bt = (const char*)(F.ws + WS_WOUT0); P.y1 = RBb; P.stats = WSP(f32x2, WS_STATS);
        P.x = args.in[0]; P.meta = args.in[1]; P.hres = nullptr;
        gemm_skew(F); pg8::gemm_phase(F.lds, P);
    } SEAM(4);
    if (IN(5)) REPS(5) { if (MK_DEBUG_ORACLE) dbg_sample_bf16(F, 3, RBb, NTOK); p4_ln_route(F, args, 0, RBb, RC); } SEAM(5);
    if (IN(6)) REPS(6) {
        if (MK_DEBUG_ORACLE) { dbg_sample_bf16(F, 4, RC, NTOK); dbg_sample_gate(F, 5); }
        const int total = moe_tables(F, 0);
        ProbUp P; P.Abase = (const char*)RC; P.ord.tbl = tbl; P.ord.c = F.bid; P.ord.total = total; P.gu = (const char*)(F.ws + WS_GU); P.list = WSP(const int, WS_LIST); P.hid = RA; P.mcnt = WSP(unsigned, WS_CTL) + CW_MOE;
        gemm_skew(F); pg8::gemm_phase(F.lds, P);
    }
SEAM(6);
    if (IN(7)) REPS(7) {
        const int total = moe_tables(F, 0);
        ProbDown P; P.Abase = (const char*)RA; P.ord.tbl = tbl; P.ord.c = F.bid; P.ord.total = total; P.dn = (const char*)(F.ws + WS_DN); P.list = WSP(const int, WS_LIST); P.tokgate = WSP(const float, WS_TOKGATE); P.cbuf = RE; P.mcnt = WSP(unsigned, WS_CTL) + CW_MOE; P.tmo = WSP(unsigned, WS_CTL) + CW_TMO;
        gemm_skew(F); pg8::gemm_phase(F.lds, P);
    } SEAM(7);
    if (IN(8)) REPS(8) {
        if (MK_DEBUG_ORACLE) dbg_sample_c(F, 6, RE);
#ifndef MK_SUBREP
#define MK_SUBREP 0
#endif
        for (int sr_ = 0; sr_ < ((MK_SUBREP == 1) ? 2 : 1); ++sr_) p7_combine<false>(F, args, 0, RC, RE, RA, nullptr);
    } SEAM(8);
    if (IN(9)) REPS(9) {
        if (MK_DEBUG_ORACLE) dbg_sample_bf16(F, 7, RA, NTOK);
        meta_in1(F);
        ProbIn1 P; P.Abase = (const char*)RA; P.ord.init(TREAL / 256, 12, F.G, F.bid); P.Bt = (const char*)(F.ws + WS_WIN1); P.bg = RBb; P.z = RC;
#ifndef MK_EPI_PROBE
#define MK_EPI_PROBE 0
#endif
        gemm_skew(F); pg8::gemm_phase(F.lds, P, MK_EPI_PROBE);
    } SEAM(9);
    if (IN(10)) REPS(10) { if (MK_DEBUG_ORACLE) { dbg_sample_bf16(F, 8, RBb, TREAL); dbg_sample_bf16(F, 9, RC, NTOK); } p9_convgate(F, args, RBb, RC, RE); } SEAM(10);
    if (IN(11)) REPS(11) {
        if (MK_DEBUG_ORACLE) dbg_sample_bf16(F, 10, RE, TREAL);
        ProbOut<false> P; P.Abase = (const char*)RE; P.ord.init(TREAL / 256, 4, F.G, F.bid); P.Bt = (const char*)(F.ws + WS_WOUT1); P.y1 = RBb; P.stats = WSP(f32x2, WS_STATS);
        P.x = nullptr; P.meta = nullptr; P.hres = RA;
        gemm_skew(F); pg8::gemm_phase(F.lds, P);
    } SEAM(11);
    if (IN(12)) REPS(12) { if (MK_DEBUG_ORACLE) dbg_sample_bf16(F, 11, RBb, TREAL); p4_ln_route(F, args, 1, RBb, RC); } SEAM(12);
    if (IN(13)) REPS(13) {
        if (MK_DEBUG_ORACLE) { dbg_sample_bf16(F, 12, RC, TREAL); dbg_sample_gate(F, 13); }
        const int total = moe_tables(F, 1);
        ProbUp P; P.Abase = (const char*)RC; P.ord.tbl = tbl; P.ord.c = F.bid; P.ord.total = total; P.gu = (const char*)(F.ws + WS_GU1); P.list = WSP(const int, WS_LIST); P.hid = RA; P.mcnt = WSP(unsigned, WS_CTL) + CW_MOE + 32768;
        gemm_skew(F); pg8::gemm_phase(F.lds, P);
    }
SEAM(13);
    if (IN(14)) REPS(14) {
        const int total = moe_tables(F, 1);
        ProbDown P; P.Abase = (const char*)RA; P.ord.tbl = tbl; P.ord.c = F.bid; P.ord.total = total; P.dn = (const char*)(F.ws + WS_DN1); P.list = WSP(const int, WS_LIST); P.tokgate = WSP(const float, WS_TOKGATE); P.cbuf = RE; P.mcnt = WSP(unsigned, WS_CTL) + CW_MOE + 32768; P.tmo = WSP(unsigned, WS_CTL) + CW_TMO;
        gemm_skew(F); pg8::gemm_phase(F.lds, P);
    } SEAM(14);
    if (IN(15)) REPS(15) { if (MK_DEBUG_ORACLE) dbg_sample_c(F, 14, RE); p7_combine<true>(F, args, 1, RC, RE, nullptr, args.out); }
    if (MK_TIME_PHASE >= 0 && F.bid == 0 && F.tid == 0) {
        STAMP[16] = __builtin_amdgcn_s_memrealtime();
        const unsigned long long T = MK_EPI_PROBE ? STAMP[20] : (STAMP[MK_TIME_PHASE + 1] - STAMP[MK_TIME_PHASE]);
        const unsigned long long t0 = __builtin_amdgcn_s_memrealtime();
        while (__builtin_amdgcn_s_memrealtime() - t0 < 4ull * T) __builtin_amdgcn_s_sleep(8);
    }
#undef IN
#undef SEAM
}
#if MK_DEBUG_ORACLE
static void dbg_oracle(void* const* d_in, void* d_out, void* d_ws, hipStream_t st);
#endif
extern "C" void kernel_launch(void* const* d_in, const int* in_sizes, int n_in, void* d_out, int out_size, void* d_ws, size_t ws_size, hipStream_t stream) {
    static int grid = 0;
    if (grid == 0) {
        int dev = 0, cus = 0;
        if (hipGetDevice(&dev) != hipSuccess || hipDeviceGetAttribute(&cus, hipDeviceAttributeMultiprocessorCount, dev) != hipSuccess) { fprintf(stderr, "kernel_launch: device query failed\n"); grid = -1; return; }
        if (hipFuncSetAttribute((const void*)mk_fwd, hipFuncAttributeMaxDynamicSharedMemorySize, LDS_BYTES) != hipSuccess) { fprintf(stderr, "kernel_launch: hipFuncSetAttribute failed\n"); grid = -1; return; }
        int per_cu = 0;
        if (hipOccupancyMaxActiveBlocksPerMultiprocessor(&per_cu, (const void*)mk_fwd, 512, LDS_BYTES) != hipSuccess || per_cu < 1) fprintf(stderr, "kernel_launch: occupancy query reports %d blocks per CU\n", per_cu);
        (void)hipGetLastError();
        grid = cus;
        if (n_in != 23 || ws_size < WS_END2) fprintf(stderr, "kernel_launch: unexpected n_in %d / ws_size %zu (need %zu)\n", n_in, ws_size, (size_t)WS_END2);
    }
    if (grid < 0) return;
    (void)hipMemsetAsync((char*)d_ws + WS_CTL, 0, CTL_ZERO_BYTES, stream);
    Args a{};
    for (int i = 0; i < 23; ++i) a.in[i] = (const float*)d_in[i];
    a.out = (float*)d_out; a.ws = (unsigned char*)d_ws;
    if (MK_N_LAUNCHES == 1) {
        a.ph_lo = 0; a.ph_hi = 16;
        hipLaunchKernelGGL(mk_fwd, dim3(grid), dim3(512), LDS_BYTES, stream, a);
    } else {
        for (int p = 0; p < 16; ++p) { a.ph_lo = p; a.ph_hi = p + 1; hipLaunchKernelGGL(mk_fwd, dim3(grid), dim3(512), LDS_BYTES, stream, a); }
    }
#if MK_DEBUG_ORACLE
    dbg_oracle(d_in, d_out, d_ws, stream);
#endif
}
```

```cpp
#include <hip/hip_runtime.h>
#include <cstdio>
#include <cstdint>

#ifndef MK_N_LAUNCHES
#define MK_N_LAUNCHES 1
#endif
#ifndef MK_DEBUG_ORACLE
#define MK_DEBUG_ORACLE 0
#endif

#define GAS __attribute__((address_space(1)))
#define LAS __attribute__((address_space(3)))
typedef unsigned short bf16_t;
typedef short bf16x8 __attribute__((ext_vector_type(8)));
typedef float f32x4 __attribute__((ext_vector_type(4)));
typedef float f32x2 __attribute__((ext_vector_type(2)));
typedef unsigned u32x4 __attribute__((ext_vector_type(4)));
typedef unsigned u32x2 __attribute__((ext_vector_type(2)));
typedef GAS unsigned gu32;

constexpr int D = 1024, NB = 4, SEQ = 8192, NMETA = 16;
constexpr int TREAL = NB * SEQ;
constexpr int NTOK = TREAL + NMETA;
constexpr int R = 33024;
constexpr int NE = 32, NG = 4, DE = 512;
constexpr int CAP = 32800;
constexpr int MAXMT = 288;
constexpr int HIDROWS = MAXMT * 256 + 256;
constexpr float ALPHA = 1.41421356237309515f;
constexpr float LN_EPS = 1e-5f;
constexpr int NPHASES = 15;

constexpr size_t MiB = 1u << 20;
constexpr size_t WS_CTL = 0, CTL_ZERO_BYTES = 32768;
constexpr size_t WS_LIST = 1 * MiB;
constexpr size_t WS_TOKGATE = 6 * MiB + 128 * 1024;
constexpr size_t WS_STATS = 6 * MiB + 512 * 1024;
constexpr size_t WS_SCANSUM = 5 * MiB + 64 * 1024;
constexpr size_t WS_WRF = 11 * MiB + 256 * 1024;
constexpr size_t WS_WAT = 11 * MiB + 512 * 1024;
constexpr size_t WS_WIN0 = 12 * MiB;
constexpr size_t WS_WOUT0 = 16 * MiB;
constexpr size_t WS_WIN1 = 18 * MiB;
constexpr size_t WS_WOUT1 = 24 * MiB;
constexpr size_t WS_GU = 26 * MiB;
constexpr size_t WS_DN = 90 * MiB;
constexpr size_t RB_BYTES = (size_t)R * D * 2;
constexpr size_t WS_RA = 122 * MiB;
constexpr size_t WS_RB = WS_RA + RB_BYTES;
constexpr size_t WS_RC = WS_RB + RB_BYTES;
constexpr size_t WS_RE = WS_RC + RB_BYTES;
constexpr size_t WS_END = WS_RE + 2 * RB_BYTES;
static_assert((size_t)HIDROWS * DE * 2 <= 2 * RB_BYTES, "HID fits RA+RB");
static_assert(WS_STATS + (size_t)R * 16 * 8 <= WS_WRF && WS_LIST + (size_t)NE * CAP * 4 <= WS_SCANSUM && WS_SCANSUM + (1u << 20) <= WS_TOKGATE && WS_TOKGATE + (size_t)2 * R * 4 <= WS_STATS, "small buffers");
constexpr size_t WS_GU1 = WS_END;
constexpr size_t WS_DN1 = WS_GU1 + 64 * MiB;
constexpr size_t WS_END2 = WS_DN1 + 32 * MiB;
constexpr size_t WS_DIGEST = WS_END2;
constexpr int CW_CNT = 64;
constexpr int CW_DBG = 256;
constexpr int CW_BAR = 4096;
constexpr int CW_MOE = 32768;
constexpr int CW_TMO = 16;

constexpr int RING_BYTES = 131072;
constexpr int SMALL_OFF = RING_BYTES;
constexpr int MISC_OFF = 160 * 1024 - 2048;
constexpr int LDS_BYTES = 160 * 1024;

#define RLX_AGENT __ATOMIC_RELAXED, __HIP_MEMORY_SCOPE_AGENT
#define LDS_WAIT() asm volatile("s_waitcnt lgkmcnt(0)" ::: "memory")
#define VM_WAIT() asm volatile("s_waitcnt vmcnt(0)" ::: "memory")

__device__ __forceinline__ unsigned cvt_pk_bf16(float lo, float hi) { unsigned r; asm volatile("v_cvt_pk_bf16_f32 %0, %1, %2" : "=v"(r) : "v"(lo), "v"(hi)); return r; }
__device__ __forceinline__ float bf_lo(unsigned w) { return __builtin_bit_cast(float, w << 16); }
__device__ __forceinline__ float bf_hi(unsigned w) { return __builtin_bit_cast(float, w & 0xffff0000u); }
__device__ __forceinline__ float bf1(unsigned short h) { return __builtin_bit_cast(float, ((unsigned)h) << 16); }
__device__ __forceinline__ void unpack8(const u32x4 w, float (&f)[8]) {
    f[0] = bf_lo(w.x); f[1] = bf_hi(w.x); f[2] = bf_lo(w.y); f[3] = bf_hi(w.y); f[4] = bf_lo(w.z); f[5] = bf_hi(w.z); f[6] = bf_lo(w.w); f[7] = bf_hi(w.w);
}
__device__ __forceinline__ u32x4 pack8(const float (&f)[8]) {
    u32x4 w; w.x = cvt_pk_bf16(f[0], f[1]); w.y = cvt_pk_bf16(f[2], f[3]); w.z = cvt_pk_bf16(f[4], f[5]); w.w = cvt_pk_bf16(f[6], f[7]); return w;
}
__device__ __forceinline__ float fast_sigmoid(float x) { return __builtin_amdgcn_rcpf(1.0f + __builtin_amdgcn_exp2f(-1.44269504089f * x)); }
__device__ __forceinline__ float gelu_tanh_f(float x) {
    const float z2 = 1.5957691216f * (x + 0.044715f * x * x * x);
    return x * fast_sigmoid(z2);
}
__device__ __forceinline__ float wave_sum(float v) {
#pragma unroll
    for (int o = 1; o < 64; o <<= 1) v += __shfl_xor(v, o);
    return v;
}
namespace pg8 {
constexpr int BM = 256, BK = 64, HALF = 128, HTB = HALF * BK * 2  , STAGE_BYTES = 8 * HTB, NXCD = 8, WGM = 8;
__host__ __device__ __forceinline__ int lds_byte(int r, int c) { const int st = (r >> 4) * 2 + (c >> 5), rr = r & 15, cc = c & 31, ob = rr * 64 + cc * 2; return st * 1024 + (ob ^ (((ob >> 9) & 1) << 5)); }
__host__ __device__ __forceinline__ void stage_rc(int b, int& R_, int& C_) { const int st = b / 1024, sb = b % 1024, swz = sb ^ (((sb >> 9) & 1) << 5); R_ = (st >> 1) * 16 + swz / 64; C_ = (st & 1) * 32 + (swz % 64) / 2; }
__host__ __device__ __forceinline__ int perm32(int rho) { const int n = rho >> 4, i = rho & 15; return 8 * (i >> 2) + 4 * n + (i & 3); }

struct Unit { int pm, pn, e, lt, hf; };

struct DenseOrder {
    int nM, nN, nwg, G, c;
    __device__ __forceinline__ void init(int nM_, int nN_, int G_, int c_) { nM = nM_; nN = nN_; nwg = nM * nN; G = G_; c = c_; }
    __device__ __forceinline__ bool next(int i, Unit& u) const {
        const long L = (long)i * G + c; if (L >= nwg) return false;
        int wgid = (int)L; { const int q = nwg / NXCD, r = nwg % NXCD, xcd = wgid % NXCD, off = wgid / NXCD; wgid = (xcd < r ? xcd * (q + 1) : r * (q + 1) + (xcd - r) * q) + off; }
        const int nig = WGM * nN, gid = wgid / nig, fm = gid * WGM, gsz = (nM - fm) < WGM ? (nM - fm) : WGM;
        u.pm = fm + ((wgid % nig) % gsz); u.pn = (wgid % nig) / gsz; u.e = 0; u.lt = 0; u.hf = 0; return true;
    }
};

template <class P>
__device__ __forceinline__ void gemm_phase(LAS unsigned char* lds, const P& prob, int probe = 0) {
    constexpr bool ALIGN_EPI = true;
    const int tid = threadIdx.x, wid = __builtin_amdgcn_readfirstlane(tid >> 6), lane = tid & 63, wr = wid >> 2, wc = wid & 3, fr = lane & 15, fq = lane >> 4;
    constexpr int K = P::K, nt = K / BK;
    int R0, C0; stage_rc(tid * 16, R0, C0);
    unsigned voffB[2];
#pragma unroll
    for (int i = 0; i < 2; ++i) { const int Rr = R0 + 64 * i; const int Rb = (Rr & ~31) + perm32(Rr & 31); voffB[i] = (unsigned)(Rb * K + C0) * 2u; }
    unsigned voffA[2][2];
    constexpr size_t kstep = (size_t)(BK * 2);
    constexpr size_t hstepB = (size_t)HALF * K * 2;
    const unsigned ldsw = (unsigned)wid * 1024u;
    const int aoff = lds_byte(wr * 64 + fr, fq * 8), boff = lds_byte(wc * 32 + fr, fq * 8);
#define PG8_SA(b, h) (((b) * 2 + (h)) * HTB)
#define PG8_SB(b, h) ((4 + (b) * 2 + (h)) * HTB)
#define PG8_STAGE(bufoff, gbase, voff) do { _Pragma("unroll") for (int _i = 0; _i < 2; ++_i) \
        __builtin_amdgcn_global_load_lds((const unsigned*)((const char*)(gbase) + (voff)[_i]), (LAS unsigned*)(lds + (bufoff) + ldsw + _i * 8192), 16, 0, 0); } while (0)
#define PG8_STAGE_A(bufoff, gbase, h) do { _Pragma("unroll") for (int _i = 0; _i < 2; ++_i) { const unsigned _va = P::GATHER ? voffA[h][_i] : (voffA[0][0] + (unsigned)(((h) * 128 + _i * 64) * K * 2)); \
        __builtin_amdgcn_global_load_lds((const unsigned*)((const char*)(gbase) + _va), (LAS unsigned*)(lds + (bufoff) + ldsw + _i * 8192), 16, 0, P::A_AUX); } } while (0)
#define PG8_LDA(dst, b, h) do { _Pragma("unroll") for (int m = 0; m < 4; ++m) _Pragma("unroll") for (int k = 0; k < 2; ++k) dst[m][k] = *(const LAS bf16x8*)(lds + PG8_SA(b, h) + aoff + m * 2048 + k * 1024); } while (0)
#define PG8_LDB(dst, b, h) do { _Pragma("unroll") for (int n = 0; n < 2; ++n) _Pragma("unroll") for (int k = 0; k < 2; ++k) dst[n][k] = *(const LAS bf16x8*)(lds + PG8_SB(b, h) + boff + n * 2048 + k * 1024); } while (0)
#define PG8_MMA(ai, bj, At, Bt) do { __builtin_amdgcn_s_setprio(1); _Pragma("unroll") for (int m = 0; m < 4; ++m) _Pragma("unroll") for (int n = 0; n < 2; ++n) _Pragma("unroll") for (int k = 0; k < 2; ++k) \
        acc[ai][bj][m][n] = __builtin_amdgcn_mfma_f32_16x16x32_bf16(Bt[n][k], At[m][k], acc[ai][bj][m][n], 0, 0, 0); __builtin_amdgcn_s_setprio(0); } while (0)
#define PG8_WAIT_V(n) asm volatile("s_waitcnt vmcnt(" #n ")" ::: "memory")
#define PG8_WAIT_L(n) asm volatile("s_waitcnt lgkmcnt(" #n ")" ::: "memory")
#define PG8_BAR __builtin_amdgcn_s_barrier()
#define PG8_SCHED __builtin_amdgcn_sched_barrier(0)
    Unit cur, nxt, prv; int ui = 0; bool have_prv = false;
    unsigned long long pr_sum = 0, pr_t0 = 0; const bool pr_on = (probe != 0) && blockIdx.x == 0 && wid == 0;
    if (!prob.next(0, cur)) return;
    f32x4 acc[2][2][4][2];
#pragma unroll
    for (int a = 0; a < 2; ++a)
#pragma unroll
        for (int b = 0; b < 2; ++b)
#pragma unroll
            for (int m = 0; m < 4; ++m)
#pragma unroll
                for (int n = 0; n < 2; ++n) acc[a][b][m][n] = (f32x4){0.f, 0.f, 0.f, 0.f};
    bf16x8 At[4][2], B0[2][2], B1[2][2];
    const char* const Ab = prob.Abase;
    const char* cB = prob.b_ptr(cur);
    prob.a_ready(cur);
    prob.a_off(cur, R0, C0 * 2, voffA);
    PG8_STAGE(PG8_SB(0, 0), cB, voffB); PG8_STAGE(PG8_SB(0, 1), cB + hstepB, voffB); PG8_STAGE_A(PG8_SA(0, 0), Ab, 0); PG8_STAGE_A(PG8_SA(0, 1), Ab, 1);
    if (wr == 1) PG8_BAR;
    PG8_WAIT_V(2); PG8_BAR;
    PG8_STAGE(PG8_SB(1, 0), cB + kstep, voffB); PG8_STAGE_A(PG8_SA(1, 0), Ab + kstep, 0); PG8_STAGE(PG8_SB(1, 1), cB + hstepB + kstep, voffB);
    PG8_WAIT_V(6); PG8_BAR;
    for (;;) {
        const bool has_next = prob.next(ui + 1, nxt);
        const char* nB = has_next ? prob.b_ptr(nxt) : cB;
#pragma nounroll
        for (int t = 0; t < nt; t += 2) {
            const bool last = (t == nt - 2);
            const char* a1 = Ab + (size_t)(t + 1) * kstep;
            const char* a2 = last ? Ab : Ab + (size_t)(t + 2) * kstep; const char* b2 = last ? nB : cB + (size_t)(t + 2) * kstep;
            const char* a3 = a2 + kstep; const char* b3 = b2 + kstep;
            if (last && has_next) prob.a_ready(nxt);
            if (pr_on && probe == 2 && t == 0) pr_t0 = __builtin_amdgcn_s_memrealtime();
            PG8_LDB(B0, 0, 0); PG8_LDB(B1, 0, 1); PG8_SCHED; PG8_LDA(At, 0, 0); PG8_STAGE_A(PG8_SA(1, 1), a1, 1);
            if (last && has_next) prob.a_off(nxt, R0, C0 * 2, voffA);
            PG8_WAIT_V(8); PG8_WAIT_L(0); PG8_BAR; if (pr_on && probe == 2 && t == 0) pr_sum += __builtin_amdgcn_s_memrealtime() - pr_t0; PG8_MMA(0, 0, At, B0); PG8_MMA(0, 1, At, B1); PG8_BAR; PG8_SCHED;
            PG8_LDA(At, 0, 1); PG8_STAGE(PG8_SB(0, 0), b2, voffB); PG8_STAGE(PG8_SB(0, 1), b2 + hstepB, voffB); PG8_STAGE_A(PG8_SA(0, 0), a2, 0);
            PG8_WAIT_V(8); PG8_WAIT_L(0); PG8_BAR; if (cur.hf == 0) { PG8_MMA(1, 0, At, B0); PG8_MMA(1, 1, At, B1); } PG8_BAR; PG8_SCHED;
            PG8_LDB(B0, 1, 0); PG8_LDB(B1, 1, 1); PG8_SCHED; PG8_LDA(At, 1, 0); PG8_STAGE_A(PG8_SA(0, 1), a2, 1);
            PG8_WAIT_V(8); PG8_WAIT_L(0); PG8_BAR; PG8_MMA(0, 0, At, B0); PG8_MMA(0, 1, At, B1); PG8_BAR; PG8_SCHED;
            PG8_LDA(At, 1, 1); PG8_STAGE(PG8_SB(1, 0), b3, voffB); PG8_STAGE(PG8_SB(1, 1), b3 + hstepB, voffB); PG8_STAGE_A(PG8_SA(1, 0), a3, 0);
            PG8_WAIT_V(8); PG8_WAIT_L(0); PG8_BAR; if (cur.hf == 0) { PG8_MMA(1, 0, At, B0); PG8_MMA(1, 1, At, B1); } PG8_BAR; PG8_SCHED;
        }
        if (pr_on && probe == 1) pr_t0 = __builtin_amdgcn_s_memrealtime();
        if constexpr (ALIGN_EPI) { if (wr == 0) PG8_BAR; }
        if (have_prv) prob.done(prv);
        prob.epi(acc, cur, wr, wc, fr, fq);
        prv = cur; have_prv = true;
        if (!has_next) break;
#pragma unroll
        for (int a = 0; a < 2; ++a)
#pragma unroll
            for (int b = 0; b < 2; ++b)
#pragma unroll
                for (int m = 0; m < 4; ++m)
#pragma unroll
                    for (int n = 0; n < 2; ++n) acc[a][b][m][n] = (f32x4){0.f, 0.f, 0.f, 0.f};
        cur = nxt; cB = nB; ++ui;
        if constexpr (ALIGN_EPI) { if (wr == 1) PG8_BAR; }
        if (pr_on && probe == 1) pr_sum += __builtin_amdgcn_s_memrealtime() - pr_t0;
    }
    if (pr_on && (threadIdx.x & 63) == 0) *(volatile LAS unsigned long long*)(lds + MISC_OFF + 1024 + 8 * 20) = pr_sum;
    PG8_WAIT_V(0);
    prob.done(prv);
    if constexpr (!ALIGN_EPI) { if (wr == 0) PG8_BAR; }
    PG8_BAR;
#undef PG8_SA
#undef PG8_SB
#undef PG8_STAGE
#undef PG8_STAGE_A
#undef PG8_LDA
#undef PG8_LDB
#undef PG8_MMA
#undef PG8_WAIT_V
#undef PG8_WAIT_L
#undef PG8_BAR
#undef PG8_SCHED
}
}
using pg8::Unit;
typedef f32x4 acc_t[2][2][4][2];

struct DenseA {
    static constexpr bool GATHER = false; static constexpr int A_AUX = 0;
    const char* Abase; pg8::DenseOrder ord;
    __device__ __forceinline__ bool next(int i, Unit& u) const { return ord.next(i, u); }
    __device__ __forceinline__ void a_ready(const Unit&) const {}
    __device__ __forceinline__ void done(const Unit&) const {}
    template <int K> __device__ __forceinline__ void a_off_k(const Unit& u, int R0, int C2, unsigned (&vo)[2][2]) const {
#pragma unroll
        for (int h = 0; h < 2; ++h)
#pragma unroll
            for (int i = 0; i < 2; ++i) vo[h][i] = (unsigned)((u.pm * 256 + h * 128 + R0 + 64 * i) * K * 2 + C2);
    }
};

struct ProbIn0 : DenseA {
    static constexpr int K = 1024;
    const char* Bt; bf16_t* ybr; bf16_t* xraw;
    __device__ __forceinline__ void a_off(const Unit& u, int R0, int C2, unsigned (&vo)[2][2]) const { a_off_k<K>(u, R0, C2, vo); }
    __device__ __forceinline__ const char* b_ptr(const Unit& u) const { return Bt + (size_t)u.pn * 256 * K * 2; }
    __device__ __forceinline__ void epi(const acc_t& acc, const Unit& u, int wr, int wc, int fr, int fq) const {
        const bool left = u.pn < 4;
        bf16_t* base = left ? ybr : xraw;
        const int col0 = (u.pn & 3) * 256 + wc * 32 + 8 * fq, row0 = u.pm * 256 + wr * 64 + fr;
#pragma unroll
        for (int ai = 0; ai < 2; ++ai)
#pragma unroll
            for (int m = 0; m < 4; ++m) { bf16_t* rowp = base + (size_t)(row0 + ai * 128 + m * 16) * D + col0;
#pragma unroll
                for (int bj = 0; bj < 2; ++bj) { f32x4 v0 = acc[ai][bj][m][0], v1 = acc[ai][bj][m][1];
                    if (left) {
#pragma unroll
                        for (int j = 0; j < 4; ++j) { v0[j] = gelu_tanh_f(v0[j]); v1[j] = gelu_tanh_f(v1[j]); } }
                    u32x4 w; w.x = cvt_pk_bf16(v0[0], v0[1]); w.y = cvt_pk_bf16(v0[2], v0[3]); w.z = cvt_pk_bf16(v1[0], v1[1]); w.w = cvt_pk_bf16(v1[2], v1[3]);
                    *(u32x4*)(rowp + bj * 128) = w; } }
    }
};

template <bool RES_F32> struct ProbOut : DenseA {
    static constexpr int K = 1024;
    const char* Bt; bf16_t* y1; f32x2* stats;
    const float* x; const float* meta;
    const bf16_t* hres;
    __device__ __forceinline__ void a_off(const Unit& u, int R0, int C2, unsigned (&vo)[2][2]) const { a_off_k<K>(u, R0, C2, vo); }
    __device__ __forceinline__ const char* b_ptr(const Unit& u) const { return Bt + (size_t)u.pn * 256 * K * 2; }
    __device__ __forceinline__ void epi(const acc_t& acc, const Unit& u, int wr, int wc, int fr, int fq) const {
        const int col0 = u.pn * 256 + wc * 32 + 8 * fq, row0 = u.pm * 256 + wr * 64 + fr;
#pragma unroll
        for (int ai = 0; ai < 2; ++ai) {
            f32x4 rf[4][2][2]; u32x4 rh[4][2]; float al[4];
#pragma unroll
            for (int m = 0; m < 4; ++m) {
                const int row = row0 + ai * 128 + m * 16;
                if (RES_F32) { const int rc = row < NTOK ? row : NTOK - 1; const float* rp = ((rc < TREAL) ? (x + (size_t)rc * D) : (meta + (size_t)(rc - TREAL) * D)) + col0; al[m] = row < NTOK ? ALPHA : 0.f;
#pragma unroll
                    for (int bj = 0; bj < 2; ++bj) { rf[m][bj][0] = *(const f32x4*)(rp + bj * 128); rf[m][bj][1] = *(const f32x4*)(rp + bj * 128 + 4); } }
                else { const bf16_t* hp = hres + (size_t)row * D + col0; al[m] = ALPHA;
#pragma unroll
                    for (int bj = 0; bj < 2; ++bj) rh[m][bj] = *(const u32x4*)(hp + bj * 128); }
            }
#pragma unroll
            for (int m = 0; m < 4; ++m) {
                const int row = row0 + ai * 128 + m * 16;
                float s1 = 0.f, s2 = 0.f;
                bf16_t* rowp = y1 + (size_t)row * D + col0;
#pragma unroll
                for (int bj = 0; bj < 2; ++bj) {
                    float r8[8];
                    if (RES_F32) { const f32x4 a = rf[m][bj][0], b = rf[m][bj][1]; r8[0] = a[0]; r8[1] = a[1]; r8[2] = a[2]; r8[3] = a[3]; r8[4] = b[0]; r8[5] = b[1]; r8[6] = b[2]; r8[7] = b[3]; }
                    else unpack8(rh[m][bj], r8);
                    float v[8];
#pragma unroll
                    for (int j = 0; j < 4; ++j) { v[j] = acc[ai][bj][m][0][j] + al[m] * r8[j]; v[4 + j] = acc[ai][bj][m][1][j] + al[m] * r8[4 + j]; }
#pragma unroll
                    for (int j = 0; j < 8; ++j) { s1 += v[j]; s2 += v[j] * v[j]; }
                    *(u32x4*)(rowp + bj * 128) = pack8(v);
                }
                s1 += __shfl_xor(s1, 16); s1 += __shfl_xor(s1, 32); s2 += __shfl_xor(s2, 16); s2 += __shfl_xor(s2, 32);
                if (fq == 0) stats[(size_t)row * 16 + u.pn * 4 + wc] = (f32x2){s1, s2};
            }
        }
    }
};

struct ProbIn1 : DenseA {
    static constexpr int K = 1024;
    const char* Bt; bf16_t* bg; bf16_t* z;
    __device__ __forceinline__ void a_off(const Unit& u, int R0, int C2, unsigned (&vo)[2][2]) const { a_off_k<K>(u, R0, C2, vo); }
    __device__ __forceinline__ const char* b_ptr(const Unit& u) const { return Bt + (size_t)u.pn * 256 * K * 2; }
    __device__ __forceinline__ void epi(const acc_t& acc, const Unit& u, int wr, int wc, int fr, int fq) const {
        const int row0 = u.pm * 256 + wr * 64 + fr;
        if (u.pn < 4) {
            const int col0 = u.pn * 256 + wc * 32 + 8 * fq;
#pragma unroll
            for (int ai = 0; ai < 2; ++ai)
#pragma unroll
                for (int m = 0; m < 4; ++m) { bf16_t* rowp = bg + (size_t)(row0 + ai * 128 + m * 16) * D + col0;
#pragma unroll
                    for (int bj = 0; bj < 2; ++bj) { const f32x4 v0 = acc[ai][bj][m][0], v1 = acc[ai][bj][m][1];
                        u32x4 w; w.x = cvt_pk_bf16(v0[0], v0[1]); w.y = cvt_pk_bf16(v0[2], v0[3]); w.z = cvt_pk_bf16(v1[0], v1[1]); w.w = cvt_pk_bf16(v1[2], v1[3]);
                        *(u32x4*)(rowp + bj * 128) = w; } }
        } else {
            const int col0 = (u.pn - 4) * 128 + wc * 32 + 8 * fq;
#pragma unroll
            for (int ai = 0; ai < 2; ++ai)
#pragma unroll
                for (int m = 0; m < 4; ++m) { bf16_t* rowp = z + (size_t)(row0 + ai * 128 + m * 16) * D + col0;
                    const f32x4 v0 = acc[ai][0][m][0] * acc[ai][1][m][0], v1 = acc[ai][0][m][1] * acc[ai][1][m][1];
                    u32x4 w; w.x = cvt_pk_bf16(v0[0], v0[1]); w.y = cvt_pk_bf16(v0[2], v0[3]); w.z = cvt_pk_bf16(v1[0], v1[1]); w.w = cvt_pk_bf16(v1[2], v1[3]);
                    *(u32x4*)rowp = w; }
        }
    }
};

struct MoeOrder {
    const LAS int* tbl; int c, total;
    __device__ __forceinline__ bool next(int i, Unit& u) const {
        const int off = (c & 7) * 32 + (c >> 3);
        const int nfr = total >> 8, rem = total & 255;
        int L = i * 256 + off; u.hf = 0;
        if (rem > 0 && rem <= 128 && i == nfr) {
            if (off >= 2 * rem) return false;
            L = nfr * 256 + (off >> 1); u.hf = 1 + (off & 1);
        } else if (L >= total) return false;
        const int mt = L >> 2; u.pn = L & 3; u.pm = mt;
        int e = 0;
#pragma unroll 1
        for (int j = 1; j < NE; ++j) if (tbl[32 + j] <= mt) e = j;
        u.e = e; u.lt = mt - tbl[32 + e];
        return true;
    }
};

struct ProbUp {
    static constexpr int K = 1024; static constexpr bool GATHER = true; static constexpr int A_AUX = 0;
    const char* Abase; MoeOrder ord; const char* gu; const int* list; bf16_t* hid; unsigned* mcnt;
    __device__ __forceinline__ void a_ready(const Unit&) const {}
    __device__ __forceinline__ void done(const Unit&) const {}
    __device__ __forceinline__ bool next(int i, Unit& u) const { return ord.next(i, u); }
    __device__ __forceinline__ void a_off(const Unit& u, int R0, int C2, unsigned (&vo)[2][2]) const {
        const int cnt = ord.tbl[u.e];
#pragma unroll
        for (int h = 0; h < 2; ++h)
#pragma unroll
            for (int i = 0; i < 2; ++i) { const int rank = u.lt * 256 + (u.hf ? (u.hf - 1) * 128 : h * 128) + R0 + 64 * i;
                int tok = R - 1;
                if (rank < cnt) tok = list[u.e * CAP + rank] >> 1;
                vo[h][i] = (unsigned)(tok * (K * 2) + C2); }
    }
    __device__ __forceinline__ const char* b_ptr(const Unit& u) const { return gu + ((size_t)u.e * 1024 + (size_t)u.pn * 256) * K * 2; }
    __device__ __forceinline__ void epi(const acc_t& acc, const Unit& u, int wr, int wc, int fr, int fq) const {
        const int col0 = u.pn * 128 + wc * 32 + 8 * fq, row0 = u.pm * 256 + (u.hf == 2 ? 128 : 0) + wr * 64 + fr;
#pragma unroll
        for (int ai = 0; ai < 2; ++ai) if (ai == 0 || u.hf == 0)
#pragma unroll
            for (int m = 0; m < 4; ++m) { bf16_t* rowp = hid + (size_t)(row0 + ai * 128 + m * 16) * DE + col0;
                float v[8];
#pragma unroll
                for (int j = 0; j < 4; ++j) { const float g0 = acc[ai][0][m][0][j], g1 = acc[ai][0][m][1][j];
                    v[j] = g0 * fast_sigmoid(g0) * acc[ai][1][m][0][j]; v[4 + j] = g1 * fast_sigmoid(g1) * acc[ai][1][m][1][j]; }
                *(u32x4*)rowp = pack8(v); }
    }
};

struct ProbDown {
    static constexpr int K = 512; static constexpr bool GATHER = false; static constexpr int A_AUX = 0;
    const char* Abase; MoeOrder ord; const char* dn; const int* list; const float* tokgate; bf16_t* cbuf; unsigned* mcnt; unsigned* tmo;
    __device__ __forceinline__ void done(const Unit&) const {}
    __device__ __forceinline__ void a_ready(const Unit&) const {}
    __device__ __forceinline__ bool next(int i, Unit& u) const { return ord.next(i, u); }
    __device__ __forceinline__ void a_off(const Unit& u, int R0, int C2, unsigned (&vo)[2][2]) const {
#pragma unroll
        for (int h = 0; h < 2; ++h)
#pragma unroll
            for (int i = 0; i < 2; ++i) vo[h][i] = (unsigned)((u.pm * 256 + (u.hf == 2 ? 128 : 0) + h * 128 + R0 + 64 * i) * K * 2 + C2);
    }
    __device__ __forceinline__ const char* b_ptr(const Unit& u) const { return dn + ((size_t)u.e * 1024 + (size_t)u.pn * 256) * K * 2; }
    __device__ __forceinline__ void epi(const acc_t& acc, const Unit& u, int wr, int wc, int fr, int fq) const {
        const int cnt = ord.tbl[u.e];
        const int col0 = u.pn * 256 + wc * 32 + 8 * fq, rr0 = (u.hf == 2 ? 128 : 0) + wr * 64 + fr;
        int li[8]; float gt[8];
#pragma unroll
        for (int q = 0; q < 8; ++q) { const int rank = u.lt * 256 + rr0 + (q >> 2) * 128 + (q & 3) * 16; li[q] = list[u.e * CAP + (rank < cnt ? rank : 0)]; }
#pragma unroll
        for (int q = 0; q < 8; ++q) gt[q] = tokgate[li[q]];
#pragma unroll
        for (int ai = 0; ai < 2; ++ai)
#pragma unroll
            for (int m = 0; m < 4; ++m) {
                const int rank = u.lt * 256 + rr0 + ai * 128 + m * 16;
                const bool ok = rank < cnt && (ai == 0 || u.hf == 0);
                const float g = gt[ai * 4 + m];
                bf16_t* rowp = cbuf + (size_t)li[ai * 4 + m] * D + col0;
#pragma unroll
                for (int bj = 0; bj < 2; ++bj) { const f32x4 v0 = acc[ai][bj][m][0] * g, v1 = acc[ai][bj][m][1] * g;
                    u32x4 w; w.x = cvt_pk_bf16(v0[0], v0[1]); w.y = cvt_pk_bf16(v0[2], v0[3]); w.z = cvt_pk_bf16(v1[0], v1[1]); w.w = cvt_pk_bf16(v1[2], v1[3]);
                    if (ok) *(u32x4*)(rowp + bj * 128) = w; } }
    }
};
struct Args { const float* in[23]; float* out; unsigned char* ws; int ph_lo, ph_hi; };
struct Frame {
    LAS unsigned char* lds;
    int tid, lane, wave, bid, G;
    unsigned char* ws;
};
#define WSP(T, off) ((T*)(F.ws + (off)))

__device__ __forceinline__ void transpose_item(const float* __restrict__ W, int ldw, int k0, int n0, bf16_t* __restrict__ WT, int ldk, int drow0, LAS float* scr, int lane) {
    f32x4 v[8];
    const float* src = W + (size_t)(k0 + (lane >> 3)) * ldw + n0 + 4 * (lane & 7);
#pragma unroll
    for (int i = 0; i < 8; ++i) v[i] = __builtin_nontemporal_load((const f32x4*)(src + (size_t)(8 * i) * ldw));
#pragma unroll
    for (int i = 0; i < 8; ++i) { LAS float* d = scr + ((lane >> 3) + 8 * i) * 33 + 4 * (lane & 7); d[0] = v[i][0]; d[1] = v[i][1]; d[2] = v[i][2]; d[3] = v[i][3]; }
    LDS_WAIT(); asm volatile("" ::: "memory");
    const int c = lane & 7;
#pragma unroll
    for (int j = 0; j < 4; ++j) { const int n = (lane >> 3) + 8 * j; const LAS float* s = scr + (8 * c) * 33 + n;
        u32x4 o; o.x = cvt_pk_bf16(s[0 * 33], s[1 * 33]); o.y = cvt_pk_bf16(s[2 * 33], s[3 * 33]); o.z = cvt_pk_bf16(s[4 * 33], s[5 * 33]); o.w = cvt_pk_bf16(s[6 * 33], s[7 * 33]);
        *(u32x4*)(WT + (size_t)(drow0 + n) * ldk + k0 + 8 * c) = o; }
    LDS_WAIT(); asm volatile("" ::: "memory");
}
template <int MAP> __device__ __forceinline__ void transpose_dense_item(const float* W, int K, int N, bf16_t* WT, int item, LAS float* scr, int lane) {
    const int nblk = N / 32, kb = item / nblk, nb = item % nblk, n0 = nb * 32;
    int drow = n0;
    if (MAP == 1 && n0 >= 1024) { const int s = (n0 >= 2048) ? 1 : 0, j = n0 - 1024 - 1024 * s; drow = 1024 + 256 * (j >> 7) + 128 * s + (j & 127); }
    transpose_item(W, N, kb * 64, n0, WT, K, drow, scr, lane);
}
__device__ __forceinline__ void tr_issue(const float* __restrict__ W, int ldw, int k0, int n0, f32x4 (&v)[8], int lane) {
    const float* src = W + (size_t)(k0 + (lane >> 3)) * ldw + n0 + 4 * (lane & 7);
#pragma unroll
    for (int i = 0; i < 8; ++i) v[i] = __builtin_nontemporal_load((const f32x4*)(src + (size_t)(8 * i) * ldw));
}
__device__ __forceinline__ void tr_to_lds(const f32x4 (&v)[8], LAS float* scr, int lane) {
#pragma unroll
    for (int i = 0; i < 8; ++i) { LAS float* d = scr + ((lane >> 3) + 8 * i) * 33 + 4 * (lane & 7); d[0] = v[i][0]; d[1] = v[i][1]; d[2] = v[i][2]; d[3] = v[i][3]; }
}
__device__ __forceinline__ void tr_from_lds(bf16_t* __restrict__ WT, int ldk, int drow0, int k0, LAS float* scr, int lane) {
    LDS_WAIT(); asm volatile("" ::: "memory");
    const int c = lane & 7;
#pragma unroll
    for (int j = 0; j < 4; ++j) { const int n = (lane >> 3) + 8 * j; const LAS float* s = scr + (8 * c) * 33 + n;
        u32x4 o; o.x = cvt_pk_bf16(s[0 * 33], s[1 * 33]); o.y = cvt_pk_bf16(s[2 * 33], s[3 * 33]); o.z = cvt_pk_bf16(s[4 * 33], s[5 * 33]); o.w = cvt_pk_bf16(s[6 * 33], s[7 * 33]);
        __builtin_nontemporal_store(o, (u32x4*)(WT + (size_t)(drow0 + n) * ldk + k0 + 8 * c)); }
    LDS_WAIT(); asm volatile("" ::: "memory");
}
__device__ __forceinline__ void tr_finish(const f32x4 (&v)[8], bf16_t* __restrict__ WT, int ldk, int drow0, int k0, LAS float* scr, int lane) { tr_to_lds(v, scr, lane); tr_from_lds(WT, ldk, drow0, k0, scr, lane); }
struct MoeItem { const float* W; bf16_t* WT; int ldw, ldk, k0, n0, drow0; };
constexpr int MOE_IDS = 2 * NE * 768;
constexpr int DN_WOUT0 = 16 * 32, DN_WIN1 = 16 * 96, DN_WOUT1 = 16 * 32;
constexpr int ALL_IDS = MOE_IDS + DN_WOUT0 + DN_WIN1 + DN_WOUT1;
__device__ __forceinline__ MoeItem moe_item(const Frame& F, const Args& A, int id) {
    MoeItem m;
    if (id >= MOE_IDS) {
        int r = id - MOE_IDS; int N; int map = 0;
        if (r < DN_WOUT0) { m.W = A.in[10]; N = D; m.WT = WSP(bf16_t, WS_WOUT0); }
        else if (r < DN_WOUT0 + DN_WIN1) { r -= DN_WOUT0; m.W = A.in[11]; N = 3072; m.WT = WSP(bf16_t, WS_WIN1); map = 1; }
        else { r -= DN_WOUT0 + DN_WIN1; m.W = A.in[13]; N = D; m.WT = WSP(bf16_t, WS_WOUT1); }
        const int nblk = N / 32, kb = r / nblk, nb = r % nblk; m.ldw = N; m.ldk = D; m.k0 = kb * 64; m.n0 = nb * 32; m.drow0 = m.n0;
        if (map == 1 && m.n0 >= 1024) { const int s2 = (m.n0 >= 2048) ? 1 : 0, j = m.n0 - 1024 - 1024 * s2; m.drow0 = 1024 + 256 * (j >> 7) + 128 * s2 + (j & 127); }
        return m;
    }
    const int layer = id / (NE * 768), item = id % (NE * 768);
    const int e = item / 768, r = item % 768, kind = r >> 8, q = r & 255;
    if (kind < 2) {
        m.W = (kind ? A.in[19] : A.in[18]) + ((size_t)layer * NE + e) * D * DE; m.ldw = DE;
        m.k0 = (q >> 4) * 64; m.n0 = (q & 15) * 32; m.WT = WSP(bf16_t, layer ? WS_GU1 : WS_GU) + (size_t)e * 1024 * 1024; m.ldk = D; m.drow0 = 256 * (m.n0 >> 7) + 128 * kind + (m.n0 & 127);
    } else {
        m.W = A.in[20] + ((size_t)layer * NE + e) * DE * D; m.ldw = D;
        m.k0 = (q >> 5) * 64; m.n0 = (q & 31) * 32; m.WT = WSP(bf16_t, layer ? WS_DN1 : WS_DN) + (size_t)e * 1024 * 512; m.ldk = DE; m.drow0 = m.n0;
    }
    return m;
}
__device__ __forceinline__ void p0_prologue(const Frame& F, const Args& A) {
    LAS float* scr = (LAS float*)(F.lds + F.wave * 8448);
    const int gw = F.bid * 8 + F.wave, NGW = F.G * 8;
    const int gt = F.bid * 512 + F.tid, NT = F.G * 512;
    bf16_t* A0 = WSP(bf16_t, WS_RA);
    for (int p0 = gt; p0 < R * 128; p0 += 4 * NT) {
        f32x4 a[4], b[4];
#pragma unroll
        for (int u = 0; u < 4; ++u) { const int p = p0 + u * NT; const int r = p >> 7, c8 = (p & 127) * 8;
            const int rc = r < NTOK ? r : 0;
            const float* src = (rc < TREAL) ? (A.in[0] + (size_t)rc * D) : (A.in[1] + (size_t)(rc - TREAL) * D);
            a[u] = __builtin_nontemporal_load((const f32x4*)(src + c8)); b[u] = __builtin_nontemporal_load((const f32x4*)(src + c8 + 4)); }
#pragma unroll
        for (int u = 0; u < 4; ++u) { const int p = p0 + u * NT; const int r = p >> 7, c8 = (p & 127) * 8;
            u32x4 o; o.x = cvt_pk_bf16(a[u][0], a[u][1]); o.y = cvt_pk_bf16(a[u][2], a[u][3]); o.z = cvt_pk_bf16(b[u][0], b[u][1]); o.w = cvt_pk_bf16(b[u][2], b[u][3]);
            if (r >= NTOK) o = (u32x4){0u, 0u, 0u, 0u};
            if (r < R) *(u32x4*)(A0 + (size_t)r * D + c8) = o; }
    }
    if (F.bid == 0 && F.tid < 128) *(u32x4*)(WSP(bf16_t, WS_RC) + (size_t)(R - 1) * D + F.tid * 8) = (u32x4){0u, 0u, 0u, 0u};
    constexpr int I0 = 16 * 64;
    for (int it = gw; it < I0; it += NGW) transpose_dense_item<0>(A.in[2], D, 2048, WSP(bf16_t, WS_WIN0), it, scr, F.lane);
    bf16_t* wat = WSP(bf16_t, WS_WAT);
    for (int p = gt; p < 2 * 65536; p += NT) {
        const int which = p >> 16, q = p & 65535, hd = q >> 12, e = (q >> 6) & 63, d = q & 63;
        const float v = (which ? A.in[7] : A.in[5])[(hd * 64 + d) * 64 + e];
        wat[p] = (bf16_t)(cvt_pk_bf16(v, 0.f) & 0xffffu);
    }
    bf16_t* wrf = WSP(bf16_t, WS_WRF);
    for (int p = gt; p < 2 * 32 * 3 * 64 * 8; p += NT) {
        const int jj = p & 7, ln = (p >> 3) & 63, sb = (p >> 9) % 96, layer = p / (96 * 512), s = sb / 3, blk = sb % 3;
        const int n = blk * 16 + (ln & 15), k = 32 * s + 8 * (ln >> 4) + jj;
        float v = 0.f;
        if (n < 4) v = A.in[14][((size_t)layer * D + k) * NG + n];
        else if (n >= 16) v = A.in[16][((size_t)layer * D + k) * NE + (n - 16)];
        wrf[p] = (bf16_t)(cvt_pk_bf16(v, 0.f) & 0xffffu);
    }
}

constexpr int P2_WF = 0  , P2_CW = 16384  , P2_WV = 18432, P2_WVB = 8960  , P2_TR = 90112  ;
template <bool APPLY>
__device__ __forceinline__ void p2_lru(const Frame& F, const Args& A) {
    const bf16_t* xraw = WSP(bf16_t, WS_RC); const bf16_t* ybr = WSP(bf16_t, WS_RB); bf16_t* gout = WSP(bf16_t, WS_RA);
    float* scansum = WSP(float, WS_SCANSUM);
    LAS unsigned char* L = F.lds;
    LAS float* cwl = (LAS float*)(L + P2_CW);
    const int tid = F.tid, lane = F.lane, w = F.wave, fr = lane & 15, q = lane >> 4;
    LAS float* XCW = (LAS float*)(L + P2_WV + w * P2_WVB);
    LAS unsigned char* const YBW0 = L + P2_WV + w * P2_WVB + 4352;
    for (int u = F.bid; u < 256; u += F.G) {
        const int b = u >> 6, hd = (u >> 2) & 15, sg = u & 3, rho = sg * 8 + w;
        __syncthreads();
        { const bf16_t* wat = WSP(bf16_t, WS_WAT) + (size_t)hd * 4096;
          for (int p = tid; p < 1024; p += 512) { const int gate = p >> 9, n = (p >> 7) & 3, s2 = (p >> 6) & 1, ln = p & 63;
              *(LAS u32x4*)(L + P2_WF + p * 16) = *(const u32x4*)(wat + gate * 65536 + (16 * n + (ln & 15)) * 64 + 32 * s2 + 8 * (ln >> 4)); } }
        if (tid < 320) { const int k = tid >> 6, c = tid & 63; cwl[tid] = (k < 4) ? A.in[3][k * D + hd * 64 + c] : A.in[4][hd * 64 + c]; }
        float cba[4], cbi[4], csp[4];
#pragma unroll
        for (int n = 0; n < 4; ++n) { const int c = hd * 64 + 16 * n + fr; cba[n] = -1.44269504089f * A.in[6][c]; cbi[n] = -1.44269504089f * A.in[8][c];
            const float nl = -A.in[9][c]; csp[n] = -1.44269504089f * 8.0f * ((nl > 20.f) ? nl : log1pf(expf(nl))); }
        float hin[4] = {0.f, 0.f, 0.f, 0.f}, pin[4] = {1.f, 1.f, 1.f, 1.f};
        if (APPLY) {
#pragma unroll 1
            for (int r2 = 0; r2 < rho; ++r2) { const float* sp = scansum + (((size_t)(b * 16 + hd) * 32 + r2) * 64 + fr) * 2;
#pragma unroll
                for (int n = 0; n < 4; ++n) hin[n] = sp[n * 32] * hin[n] + sp[n * 32 + 1]; }
        }
        __syncthreads();
        const int nsc = (rho == 0) ? 17 : 16;
        const bf16_t* xbase = xraw + hd * 64 + 8 * q; const bf16_t* ybase = ybr + hd * 64 + (lane & 3) * 16;
        u32x4 xv[4][2], yv[2];
        f32x4 tv[8]; int tid_prev = -1;
        LAS float* trscr = (LAS float*)(L + P2_TR + w * 8448);
#define P2_LOAD(sc, XV, YV) do { const bool metac_ = (rho == 0 && (sc) == 0); const int P0_ = metac_ ? 0 : NMETA + rho * 256 + 16 * ((sc) - (rho == 0 ? 1 : 0)); \
            _Pragma("unroll") for (int k = 0; k < 4; ++k) { const int pos = P0_ + fr - 3 + k; \
                const size_t row = (pos < 0) ? (size_t)(R - 1)   : ((pos < NMETA) ? (size_t)(TREAL + pos) : ((size_t)b * SEQ + (pos - NMETA))); \
                XV[k][0] = *(const u32x4*)(xbase + row * D); XV[k][1] = *(const u32x4*)(xbase + row * D + 32); } \
            if (APPLY) { const int pos = P0_ + (lane >> 2); const size_t row = (pos < NMETA) ? (size_t)(TREAL + pos) : ((size_t)b * SEQ + (pos - NMETA)); \
                YV[0] = *(const u32x4*)(ybase + row * D); YV[1] = *(const u32x4*)(ybase + row * D + 8); } } while (0)
        P2_LOAD(0, xv, yv);
#define P2_GSTORE(sc, YB) do { const bool metac_ = (rho == 0 && (sc) == 0); if (!metac_ || b == 0) { \
            const int P0_ = metac_ ? 0 : NMETA + rho * 256 + 16 * ((sc) - (rho == 0 ? 1 : 0)); \
            const int pos = P0_ + (lane >> 2); const size_t row = (pos < NMETA) ? (size_t)(TREAL + pos) : ((size_t)b * SEQ + (pos - NMETA)); \
            bf16_t* gp = gout + row * D + hd * 64 + (lane & 3) * 16; \
            *(u32x4*)gp = *(const LAS u32x4*)((YB) + (lane >> 2) * 144 + ((lane & 3) * 2) * 16); \
            *(u32x4*)(gp + 8) = *(const LAS u32x4*)((YB) + (lane >> 2) * 144 + ((lane & 3) * 2 + 1) * 16); } } while (0)
#pragma unroll 1
        for (int sc = 0; sc < nsc; ++sc) {
            LAS unsigned char* const YBW = YBW0 + (sc & 1) * 2304;
            asm volatile("" ::: "memory");
            { const int idn = (APPLY ? 32768 : 0) + sc * 2048 + u * 8 + w; const int tid_next = (sc < 16 && idn < ALL_IDS) ? idn : -1;
              if (tid_prev >= 0) tr_to_lds(tv, trscr, lane);
              if (tid_next >= 0) { const MoeItem m = moe_item(F, A, tid_next); tr_issue(m.W, m.ldw, m.k0, m.n0, tv, lane); }
              if (tid_prev >= 0) { const MoeItem m = moe_item(F, A, tid_prev); tr_from_lds(m.WT, m.ldk, m.drow0, m.k0, trscr, lane); }
              tid_prev = tid_next; }
            bf16x8 af[2];
#pragma unroll
            for (int s2 = 0; s2 < 2; ++s2) {
                float xc[8];
                { const f32x4 ba = *(const LAS f32x4*)(cwl + 256 + 32 * s2 + 8 * q), bc = *(const LAS f32x4*)(cwl + 256 + 32 * s2 + 8 * q + 4);
#pragma unroll
                  for (int j = 0; j < 4; ++j) { xc[j] = ba[j]; xc[4 + j] = bc[j]; } }
#pragma unroll
                for (int k = 0; k < 4; ++k) { float xf[8]; unpack8(xv[k][s2], xf);
                    const f32x4 wa = *(const LAS f32x4*)(cwl + 64 * k + 32 * s2 + 8 * q), wb = *(const LAS f32x4*)(cwl + 64 * k + 32 * s2 + 8 * q + 4);
#pragma unroll
                    for (int j = 0; j < 4; ++j) { xc[j] += wa[j] * xf[j]; xc[4 + j] += wb[j] * xf[4 + j]; } }
                af[s2] = __builtin_bit_cast(bf16x8, pack8(xc));
                *(LAS f32x4*)(XCW + fr * 68 + 32 * s2 + 8 * q) = (f32x4){xc[0], xc[1], xc[2], xc[3]};
                *(LAS f32x4*)(XCW + fr * 68 + 32 * s2 + 8 * q + 4) = (f32x4){xc[4], xc[5], xc[6], xc[7]};
            }
            if (APPLY) { *(LAS u32x4*)(YBW + (lane >> 2) * 144 + ((lane & 3) * 2) * 16) = yv[0]; *(LAS u32x4*)(YBW + (lane >> 2) * 144 + ((lane & 3) * 2 + 1) * 16) = yv[1]; }
            LDS_WAIT(); asm volatile("" ::: "memory");
            if (sc + 1 < nsc) P2_LOAD(sc + 1, xv, yv);
            if (APPLY && sc > 0) P2_GSTORE(sc - 1, YBW0 + ((sc - 1) & 1) * 2304);
            asm volatile("" ::: "memory");
            float xcv[4][4], ybv[4][4];
#pragma unroll
            for (int n = 0; n < 4; ++n)
#pragma unroll
                for (int j = 0; j < 4; ++j) { xcv[n][j] = XCW[(4 * q + j) * 68 + 16 * n + fr];
                    if (APPLY) ybv[n][j] = bf1(*((const LAS unsigned short*)(YBW + (4 * q + j) * 144) + 16 * n + fr)); }
            float av[4][4], bv[4][4], Ap[4], Bp[4];
#pragma unroll
            for (int n = 0; n < 4; ++n) {
                f32x4 ca = (f32x4){0.f, 0.f, 0.f, 0.f}, ci = ca;
#pragma unroll
                for (int s2 = 0; s2 < 2; ++s2) { const bf16x8 fa = *(const LAS bf16x8*)(L + P2_WF + (((0 * 4 + n) * 2 + s2) * 64 + lane) * 16), fi = *(const LAS bf16x8*)(L + P2_WF + (((1 * 4 + n) * 2 + s2) * 64 + lane) * 16);
                    ca = __builtin_amdgcn_mfma_f32_16x16x32_bf16(af[s2], fa, ca, 0, 0, 0); ci = __builtin_amdgcn_mfma_f32_16x16x32_bf16(af[s2], fi, ci, 0, 0, 0); }
                Ap[n] = 1.f; Bp[n] = 0.f;
#pragma unroll
                for (int j = 0; j < 4; ++j) {
                    const float r = __builtin_amdgcn_rcpf(1.0f + __builtin_amdgcn_exp2f(__builtin_fmaf(ca[j], -1.44269504089f, cba[n])));
                    const float gi = __builtin_amdgcn_rcpf(1.0f + __builtin_amdgcn_exp2f(__builtin_fmaf(ci[j], -1.44269504089f, cbi[n])));
                    const float a = __builtin_amdgcn_exp2f(csp[n] * r);
                    const float om = __builtin_fmaf(-a, a, 1.0f);
                    av[n][j] = a; bv[n][j] = __builtin_sqrtf(om) * gi * xcv[n][j];
                    Bp[n] = a * Bp[n] + bv[n][j]; Ap[n] *= a;
                }
            }
            float Aq[4][4], Bq[4][4];
#pragma unroll
            for (int n = 0; n < 4; ++n)
#pragma unroll
                for (int q2 = 0; q2 < 4; ++q2) { Aq[n][q2] = __shfl(Ap[n], fr + 16 * q2); Bq[n][q2] = __shfl(Bp[n], fr + 16 * q2); }
#pragma unroll
            for (int n = 0; n < 4; ++n) {
                float h = hin[n];
#pragma unroll
                for (int q2 = 0; q2 < 3; ++q2) { const float hq = Aq[n][q2] * h + Bq[n][q2]; h = (q2 < q) ? hq : h; }
                if (APPLY) {
#pragma unroll
                    for (int j = 0; j < 4; ++j) { h = av[n][j] * h + bv[n][j]; ybv[n][j] *= h; }
                }
                float he = hin[n];
#pragma unroll
                for (int q2 = 0; q2 < 4; ++q2) he = Aq[n][q2] * he + Bq[n][q2];
                hin[n] = he; pin[n] *= (Aq[n][0] * Aq[n][1]) * (Aq[n][2] * Aq[n][3]);
            }
            if (APPLY) {
#pragma unroll
                for (int n = 0; n < 4; ++n)
#pragma unroll
                    for (int j = 0; j < 4; ++j) *((LAS unsigned short*)(YBW + (4 * q + j) * 144) + 16 * n + fr) = (unsigned short)(cvt_pk_bf16(ybv[n][j], 0.f) & 0xffffu);
            }
            LDS_WAIT(); asm volatile("" ::: "memory");
        }
        if (APPLY) P2_GSTORE(nsc - 1, YBW0 + ((nsc - 1) & 1) * 2304);
        if (tid_prev >= 0) { const MoeItem m = moe_item(F, A, tid_prev); tr_finish(tv, m.WT, m.ldk, m.drow0, m.k0, trscr, lane); }
#undef P2_GSTORE
#undef P2_LOAD
        if (!APPLY && q == 0) { float* sp = scansum + (((size_t)(b * 16 + hd) * 32 + rho) * 64 + fr) * 2;
#pragma unroll
            for (int n = 0; n < 4; ++n) { sp[n * 32] = pin[n]; sp[n * 32 + 1] = hin[n]; } }
    }
}
constexpr int P4_WRF = 0, P4_LNG = 98304, P4_LNB = 102400, P4_LG = 106496  , P4_HIST = SMALL_OFF, P4_BASE = SMALL_OFF + 256;
__device__ __forceinline__ void p4_ln_route(const Frame& F, const Args& A, int layer, const bf16_t* y1, bf16_t* h1) {
    LAS unsigned char* L = F.lds;
    const int tid = F.tid, lane = F.lane, w = F.wave;
    const f32x2* stats = WSP(const f32x2, WS_STATS);
    int* list = WSP(int, WS_LIST); float* tokgate = WSP(float, WS_TOKGATE);
    unsigned* cnt = WSP(unsigned, WS_CTL) + CW_CNT + 64 * layer;
    const float* lng = A.in[21] + (size_t)(layer * 2 + 0) * D; const float* lnb = A.in[22] + (size_t)(layer * 2 + 0) * D;
    const float* bgrp = A.in[15] + layer * NG; const float* bexp = A.in[17] + layer * NE;
    const int gw = F.bid * 8 + w, NGW = F.G * 8;
    constexpr int NGR = TREAL / 16;
    const int fr = lane & 15, q = lane >> 4;
    f32x4 pa0 = (f32x4){0.f, 0.f, 0.f, 0.f}, pb0 = pa0; u32x4 ypre[8];
    { const int tok0 = (gw < NGR ? gw : 0) * 16 + fr;
      pa0 = *(const f32x4*)(stats + (size_t)tok0 * 16 + 4 * q); pb0 = *(const f32x4*)(stats + (size_t)tok0 * 16 + 4 * q + 2);
#pragma unroll
      for (int s2 = 0; s2 < 8; ++s2) ypre[s2] = *(const u32x4*)(y1 + (size_t)tok0 * D + 8 * q + 32 * s2); }
    __syncthreads();
    { const u32x4* src = (const u32x4*)(WSP(bf16_t, WS_WRF) + (size_t)layer * 49152);
      for (int p = tid; p < 6144; p += 512) *(LAS u32x4*)(L + P4_WRF + p * 16) = src[p];
      for (int p = tid; p < 256; p += 512) { *(LAS f32x4*)(L + P4_LNG + p * 16) = ((const f32x4*)lng)[p]; *(LAS f32x4*)(L + P4_LNB + p * 16) = ((const f32x4*)lnb)[p]; } }
    for (int p = F.bid * 512 + tid; p < (R - NTOK) * 128; p += F.G * 512) *(u32x4*)(h1 + (size_t)(NTOK + (p >> 7)) * D + (p & 127) * 8) = (u32x4){0u, 0u, 0u, 0u};
    LAS int* hist = (LAS int*)(L + P4_HIST); LAS int* basep = (LAS int*)(L + P4_BASE);
    LAS float* LG = (LAS float*)(L + P4_LG + w * 2048);
    const int niter = (NGR + NGW - 1) / NGW;
#pragma unroll 1
    for (int it = 0; it < niter; ++it) {
        __syncthreads();
        if (tid < 32) hist[tid] = 0;
        __syncthreads();
        int e0[2] = {0, 0}, e1[2] = {0, 0}, r0[2] = {0, 0}, r1[2] = {0, 0}; float g0[2] = {0.f, 0.f}, g1[2] = {0.f, 0.f}; int tokv[2] = {0, 0}; bool act[2] = {false, false};
#pragma unroll
        for (int gi = 0; gi < 2; ++gi) {
            const int grp = (gi == 0) ? (it * NGW + gw) : NGR;
            const bool active = (gi == 0) ? (grp < NGR) : (layer == 0 && it == 0 && gw == 0);
            act[gi] = active;
            const int tok = grp * 16 + fr; tokv[gi] = tok;
            if (active) {
                const bool first = (gi == 0 && it == 0);
                f32x4 pa = pa0, pb = pb0;
                if (!first) { pa = *(const f32x4*)(stats + (size_t)tok * 16 + 4 * q); pb = *(const f32x4*)(stats + (size_t)tok * 16 + 4 * q + 2); }
                float s1 = (pa[0] + pa[2]) + (pb[0] + pb[2]), s2 = (pa[1] + pa[3]) + (pb[1] + pb[3]);
                s1 += __shfl_xor(s1, 16); s1 += __shfl_xor(s1, 32); s2 += __shfl_xor(s2, 16); s2 += __shfl_xor(s2, 32);
                const float mu = s1 * (1.f / D), var = fmaxf(s2 * (1.f / D) - mu * mu, 0.f), rstd = __builtin_amdgcn_rsqf(var + LN_EPS);
                f32x4 acc[3];
#pragma unroll
                for (int k = 0; k < 3; ++k) acc[k] = (f32x4){0.f, 0.f, 0.f, 0.f};
                const bf16_t* yrow = y1 + (size_t)tok * D + 8 * q; bf16_t* hrow = h1 + (size_t)tok * D + 8 * q;
#pragma unroll 1
                for (int half = 0; half < 4; ++half) {
                    u32x4 yb[8];
                    if (half == 0 && first) {
#pragma unroll
                        for (int s2 = 0; s2 < 8; ++s2) yb[s2] = ypre[s2];
                    } else {
#pragma unroll
                        for (int s2 = 0; s2 < 8; ++s2) yb[s2] = *(const u32x4*)(yrow + 32 * (8 * half + s2));
                    }
#pragma unroll
                    for (int s2 = 0; s2 < 8; ++s2) {
                        const int s = 8 * half + s2;
                        float y[8], g[8], bb[8], h[8];
                        unpack8(yb[s2], y);
                        const int k0 = 32 * s + 8 * q;
                        { const f32x4 ga = *(const LAS f32x4*)(L + P4_LNG + k0 * 4), gb = *(const LAS f32x4*)(L + P4_LNG + k0 * 4 + 16);
                          const f32x4 ba = *(const LAS f32x4*)(L + P4_LNB + k0 * 4), bc = *(const LAS f32x4*)(L + P4_LNB + k0 * 4 + 16);
#pragma unroll
                          for (int j = 0; j < 4; ++j) { g[j] = ga[j]; g[4 + j] = gb[j]; bb[j] = ba[j]; bb[4 + j] = bc[j]; } }
#pragma unroll
                        for (int j = 0; j < 8; ++j) h[j] = (y[j] - mu) * rstd * g[j] + bb[j];
                        const u32x4 hw = pack8(h);
                        *(u32x4*)(hrow + 32 * s) = hw;
                        const bf16x8 hb = __builtin_bit_cast(bf16x8, hw);
#pragma unroll
                        for (int blk = 0; blk < 3; ++blk) { const bf16x8 wf = *(const LAS bf16x8*)(L + P4_WRF + ((s * 3 + blk) * 64 + lane) * 16);
                            acc[blk] = __builtin_amdgcn_mfma_f32_16x16x32_bf16(wf, hb, acc[blk], 0, 0, 0); }
                    }
                }
#pragma unroll
                for (int j = 0; j < 4; ++j) { LG[fr * 32 + 4 * q + j] = acc[1][j]; LG[fr * 32 + 16 + 4 * q + j] = acc[2][j]; }
                LDS_WAIT(); asm volatile("" ::: "memory");
                if (q == 0) {
                    float gl[4]; int g = 0; float gm = -3.4e38f;
#pragma unroll
                    for (int j = 0; j < 4; ++j) { gl[j] = acc[0][j] + bgrp[j]; if (gl[j] > gm) { gm = gl[j]; g = j; } }
                    float se = 0.f;
#pragma unroll
                    for (int j = 0; j < 4; ++j) se += __expf(gl[j] - gm);
                    const float pg = 1.f / se;
                    const f32x4 la = *(const LAS f32x4*)(LG + fr * 32 + 8 * g), lb = *(const LAS f32x4*)(LG + fr * 32 + 8 * g + 4);
                    const f32x4 ba = *(const f32x4*)(bexp + 8 * g), bc = *(const f32x4*)(bexp + 8 * g + 4);
                    float el[8];
#pragma unroll
                    for (int j = 0; j < 4; ++j) { el[j] = la[j] + ba[j]; el[4 + j] = lb[j] + bc[j]; }
                    int i0 = -1, i1 = -1; float v0 = -3.4e38f, v1 = -3.4e38f;
#pragma unroll
                    for (int j = 0; j < 8; ++j) { const float v = el[j];
                        if (v > v0) { v1 = v0; i1 = i0; v0 = v; i0 = j; } else if (v > v1) { v1 = v; i1 = j; } }
                    const float ex = __expf(v1 - v0);
                    const float p0 = 1.f / (1.f + ex);
                    g0[gi] = pg * p0; g1[gi] = pg * (ex * p0);
                    e0[gi] = g * 8 + i0; e1[gi] = g * 8 + i1;
                    r0[gi] = __hip_atomic_fetch_add(&hist[e0[gi]], 1, __ATOMIC_RELAXED, __HIP_MEMORY_SCOPE_WORKGROUP); r1[gi] = __hip_atomic_fetch_add(&hist[e1[gi]], 1, __ATOMIC_RELAXED, __HIP_MEMORY_SCOPE_WORKGROUP);
                }
                LDS_WAIT(); asm volatile("" ::: "memory");
            }
        }
        __syncthreads();
        if (tid < 32) { const int hcnt = hist[tid]; basep[tid] = hcnt ? (int)__hip_atomic_fetch_add(cnt + tid, (unsigned)hcnt, RLX_AGENT) : 0; }
        __syncthreads();
#pragma unroll
        for (int gi = 0; gi < 2; ++gi) if (act[gi] && q == 0) {
            const int p0 = basep[e0[gi]] + r0[gi], p1 = basep[e1[gi]] + r1[gi];
            list[e0[gi] * CAP + p0] = 2 * tokv[gi]; list[e1[gi] * CAP + p1] = 2 * tokv[gi] + 1;
            tokgate[2 * tokv[gi]] = g0[gi]; tokgate[2 * tokv[gi] + 1] = g1[gi];
        }
    }
}

__device__ __forceinline__ int moe_tables(const Frame& F, int layer) {
    LAS int* tbl = (LAS int*)(F.lds + SMALL_OFF + 1024);
    const unsigned* cnt = WSP(const unsigned, WS_CTL) + CW_CNT + 64 * layer;
    __syncthreads();
    if (F.tid < 32) tbl[F.tid] = (int)__hip_atomic_load(cnt + F.tid, RLX_AGENT);
    __syncthreads();
    if (F.tid == 0) { int s = 0; for (int e = 0; e < NE; ++e) { tbl[32 + e] = s; s += (tbl[e] + 255) >> 8; } tbl[64] = s; }
    __syncthreads();
    return 4 * tbl[64];
}

template <bool FINAL>
__device__ __forceinline__ void p7_combine(const Frame& F, const Args& A, int layer, const bf16_t* h1, const bf16_t* cbuf, bf16_t* h2, float* out) {
    const int lane = F.lane, gw = F.bid * 8 + F.wave, NGW = F.G * 8;
    const float* lng = A.in[21] + (size_t)(layer * 2 + 1) * D; const float* lnb = A.in[22] + (size_t)(layer * 2 + 1) * D;
    float g[16], bb[16];
#pragma unroll
    for (int hx = 0; hx < 2; ++hx) { const int c0 = hx * 512 + lane * 8;
        const f32x4 ga = *(const f32x4*)(lng + c0), gb = *(const f32x4*)(lng + c0 + 4), ba = *(const f32x4*)(lnb + c0), bc = *(const f32x4*)(lnb + c0 + 4);
#pragma unroll
        for (int j = 0; j < 4; ++j) { g[hx * 8 + j] = ga[j]; g[hx * 8 + 4 + j] = gb[j]; bb[hx * 8 + j] = ba[j]; bb[hx * 8 + 4 + j] = bc[j]; } }
    const int ntok = FINAL ? TREAL : NTOK;
#pragma unroll 2
    for (int t = gw; t < ntok; t += NGW) {
        float y[16];
#pragma unroll
        for (int hx = 0; hx < 2; ++hx) { const int c0 = hx * 512 + lane * 8;
            float a[8], c0v[8], c1v[8];
            unpack8(__builtin_nontemporal_load((const u32x4*)(h1 + (size_t)t * D + c0)), a);
            unpack8(__builtin_nontemporal_load((const u32x4*)(cbuf + (size_t)(2 * t) * D + c0)), c0v);
            unpack8(__builtin_nontemporal_load((const u32x4*)(cbuf + (size_t)(2 * t + 1) * D + c0)), c1v);
#pragma unroll
            for (int j = 0; j < 8; ++j) y[hx * 8 + j] = ALPHA * a[j] + (c0v[j] + c1v[j]); }
        float s = 0.f;
#pragma unroll
        for (int j = 0; j < 16; ++j) s += y[j];
        const float mu = wave_sum(s) * (1.f / D);
        float qv = 0.f;
#pragma unroll
        for (int j = 0; j < 16; ++j) { y[j] -= mu; qv += y[j] * y[j]; }
        const float rstd = __builtin_amdgcn_rsqf(wave_sum(qv) * (1.f / D) + LN_EPS);
#pragma unroll
        for (int j = 0; j < 16; ++j) y[j] = y[j] * rstd * g[j] + bb[j];
#pragma unroll
        for (int hx = 0; hx < 2; ++hx) { const int c0 = hx * 512 + lane * 8;
            if (FINAL) { __builtin_nontemporal_store((f32x4){y[hx * 8 + 0], y[hx * 8 + 1], y[hx * 8 + 2], y[hx * 8 + 3]}, (f32x4*)(out + (size_t)t * D + c0));
                         __builtin_nontemporal_store((f32x4){y[hx * 8 + 4], y[hx * 8 + 5], y[hx * 8 + 6], y[hx * 8 + 7]}, (f32x4*)(out + (size_t)t * D + c0 + 4)); }
            else { float o[8];
#pragma unroll
                for (int j = 0; j < 8; ++j) o[j] = y[hx * 8 + j];
                *(u32x4*)(h2 + (size_t)t * D + c0) = pack8(o); } }
    }
}

__device__ __forceinline__ void p9_convgate(const Frame& F, const Args& A, const bf16_t* bg, const bf16_t* z, bf16_t* g1) {
    const float* cw = A.in[12];
    const int gt = F.bid * 512 + F.tid, NT = F.G * 512;
    for (int item = gt; item < (TREAL / 16) * 128; item += NT) {
        const int pc = item & 127, run = item >> 7, r0 = run * 16, c0 = pc * 8;
        float w0[8], w1[8], w2[8];
        { const f32x4 a = *(const f32x4*)(cw + c0), b = *(const f32x4*)(cw + c0 + 4), c = *(const f32x4*)(cw + D + c0), d = *(const f32x4*)(cw + D + c0 + 4), e = *(const f32x4*)(cw + 2 * D + c0), f = *(const f32x4*)(cw + 2 * D + c0 + 4);
#pragma unroll
          for (int j = 0; j < 4; ++j) { w0[j] = a[j]; w0[4 + j] = b[j]; w1[j] = c[j]; w1[4 + j] = d[j]; w2[j] = e[j]; w2[4 + j] = f[j]; } }
        const bool first = (r0 & (SEQ - 1)) == 0;
        const size_t rm1 = first ? (size_t)(TREAL + NMETA - 1) : (size_t)(r0 - 1), rm2 = first ? (size_t)(TREAL + NMETA - 2) : (size_t)(r0 - 2);
        float z1[8], z2[8];
        unpack8(*(const u32x4*)(z + rm1 * D + c0), z1); unpack8(*(const u32x4*)(z + rm2 * D + c0), z2);
#pragma unroll 4
        for (int j = 0; j < 16; ++j) {
            float z0[8], b[8], o[8];
            unpack8(__builtin_nontemporal_load((const u32x4*)(z + (size_t)(r0 + j) * D + c0)), z0); unpack8(__builtin_nontemporal_load((const u32x4*)(bg + (size_t)(r0 + j) * D + c0)), b);
#pragma unroll
            for (int i = 0; i < 8; ++i) { o[i] = b[i] * (w0[i] * z2[i] + w1[i] * z1[i] + w2[i] * z0[i]); z2[i] = z1[i]; z1[i] = z0[i]; }
            *(u32x4*)(g1 + (size_t)(r0 + j) * D + c0) = pack8(o);
        }
    }
}

template <int NT> __device__ __forceinline__ void meta_partials(const Frame& F, const bf16_t* a16, const bf16_t* wt, const int (&n0)[NT]) {
    const int lane = F.lane, fr = lane & 15, q = lane >> 4, w = F.wave;
    const bf16_t* ap = a16 + (size_t)fr * D + 8 * q + 128 * w;
    bf16x8 af[4], bfr[NT][4];
#pragma unroll
    for (int s = 0; s < 4; ++s) af[s] = *(const bf16x8*)(ap + 32 * s);
#pragma unroll
    for (int t = 0; t < NT; ++t) { const bf16_t* bp = wt + (size_t)(n0[t] + fr) * D + 8 * q + 128 * w;
#pragma unroll
        for (int s = 0; s < 4; ++s) bfr[t][s] = *(const bf16x8*)(bp + 32 * s); }
#pragma unroll
    for (int t = 0; t < NT; ++t) { f32x4 acc = (f32x4){0.f, 0.f, 0.f, 0.f};
#pragma unroll
        for (int s = 0; s < 4; ++s) acc = __builtin_amdgcn_mfma_f32_16x16x32_bf16(af[s], bfr[t][s], acc, 0, 0, 0);
        *(LAS f32x4*)(F.lds + ((w * NT + t) * 64 + lane) * 16) = acc; }
    __syncthreads();
}
template <int NT> __device__ __forceinline__ f32x4 meta_reduce(const Frame& F, int t) {
    f32x4 acc = (f32x4){0.f, 0.f, 0.f, 0.f};
#pragma unroll
    for (int w = 0; w < 8; ++w) acc += *(const LAS f32x4*)(F.lds + ((w * NT + t) * 64 + F.lane) * 16);
    return acc;
}
__device__ __forceinline__ bf16_t bf16_of(float v) { return (bf16_t)(cvt_pk_bf16(v, 0.f) & 0xffffu); }
__device__ __forceinline__ void meta_in0(const Frame& F) {
    const int g = F.bid; if (g >= 32) return;
    const int lane = F.lane, fr = lane & 15, q = lane >> 4;
    const int n0[4] = {g * 64, g * 64 + 16, g * 64 + 32, g * 64 + 48};
    __syncthreads();
    meta_partials<4>(F, WSP(const bf16_t, WS_RA) + (size_t)TREAL * D, WSP(const bf16_t, WS_WIN0), n0);
    if (F.wave < 4) { const int t = F.wave; const f32x4 acc = meta_reduce<4>(F, t);
        const bool left = g < 16; bf16_t* base = left ? WSP(bf16_t, WS_RB) : WSP(bf16_t, WS_RC);
#pragma unroll
        for (int j = 0; j < 4; ++j) { const float v = left ? gelu_tanh_f(acc[j]) : acc[j]; base[(size_t)(TREAL + 4 * q + j) * D + (((g * 64) & 1023) + 16 * t + fr)] = bf16_of(v); } }
    __syncthreads();
}
__device__ __forceinline__ void meta_out0(const Frame& F, const Args& A) {
    const int g = F.bid; if (g >= 16) return;
    const int lane = F.lane, fr = lane & 15, q = lane >> 4;
    const int n0[4] = {g * 64, g * 64 + 16, g * 64 + 32, g * 64 + 48};
    __syncthreads();
    meta_partials<4>(F, WSP(const bf16_t, WS_RA) + (size_t)TREAL * D, WSP(const bf16_t, WS_WOUT0), n0);
    LAS float* sp = (LAS float*)(F.lds + 65536);
    if (F.wave < 4) { const int t = F.wave; const f32x4 acc = meta_reduce<4>(F, t);
        bf16_t* y1 = WSP(bf16_t, WS_RB);
#pragma unroll
        for (int j = 0; j < 4; ++j) { const int m = 4 * q + j; const int col = g * 64 + 16 * t + fr;
            const float v = acc[j] + ALPHA * A.in[1][(size_t)m * D + col]; float s1 = v, s2 = v * v;
            y1[(size_t)(TREAL + m) * D + col] = bf16_of(v);
#pragma unroll
            for (int o = 1; o < 16; o <<= 1) { s1 += __shfl_xor(s1, o); s2 += __shfl_xor(s2, o); }
            if (fr == 0) { sp[(t * 16 + m) * 2] = s1; sp[(t * 16 + m) * 2 + 1] = s2; } } }
    __syncthreads();
    if (F.tid < 16) { const int m = F.tid; float s1 = 0.f, s2 = 0.f;
#pragma unroll
        for (int t = 0; t < 4; ++t) { s1 += sp[(t * 16 + m) * 2]; s2 += sp[(t * 16 + m) * 2 + 1]; }
        WSP(f32x2, WS_STATS)[(size_t)(TREAL + m) * 16 + g] = (f32x2){s1, s2}; }
    __syncthreads();
}
__device__ __forceinline__ void meta_in1(const Frame& F) {
    const int g = F.bid; if (g >= 16) return;
    const int lane = F.lane, fr = lane & 15, q = lane >> 4;
    const int zc0 = g * 64;
    const int r0 = 1024 + 256 * (zc0 >> 7) + (zc0 & 127);
    const int n0[8] = {r0, r0 + 16, r0 + 32, r0 + 48, r0 + 128, r0 + 144, r0 + 160, r0 + 176};
    __syncthreads();
    meta_partials<8>(F, WSP(const bf16_t, WS_RA) + (size_t)TREAL * D, WSP(const bf16_t, WS_WIN1), n0);
    if (F.wave < 4) { const int t = F.wave; const f32x4 cg = meta_reduce<8>(F, t), vv = meta_reduce<8>(F, 4 + t);
        bf16_t* z = WSP(bf16_t, WS_RC);
#pragma unroll
        for (int j = 0; j < 4; ++j) z[(size_t)(TREAL + 4 * q + j) * D + zc0 + 16 * t + fr] = bf16_of(cg[j] * vv[j]); }
    __syncthreads();
}
#define XB_TMO      128
#define XB_XCNT(j)  (256  + 64 * (j))
#define XB_XSUB(j)  (1280 + 64 * (j))
#define XB_XGEN(j)  (2304 + 64 * (j))
#define XB_TOP      3328
#define XB_TOPGEN   3392
#define XCD_BAR_WORDS 3456
#define XB_SPIN_CAP (1u << 20)
__device__ __forceinline__ unsigned xb_ld(unsigned* p)              { return __hip_atomic_load(p, __ATOMIC_RELAXED, __HIP_MEMORY_SCOPE_AGENT); }
__device__ __forceinline__ unsigned xb_add(unsigned* p, unsigned v) { return __hip_atomic_fetch_add(p, v, __ATOMIC_RELAXED, __HIP_MEMORY_SCOPE_AGENT); }
__device__ __forceinline__ unsigned xb_xcc_id() { return (unsigned)__builtin_amdgcn_s_getreg((3 << 11) | 20) & 0xFu; }
#define XB_SPIN(cond, bar) do { unsigned _sp = 0; while (cond) { __builtin_amdgcn_s_sleep(1); \
    if ((++_sp & 255u) == 0u) { if (xb_ld(&(bar)[XB_TMO])) break; if (_sp > XB_SPIN_CAP) { atomicAdd(&(bar)[XB_TMO], 1u); break; } } } } while (0)
struct XcdBarrier { unsigned* bar; unsigned x; volatile LAS unsigned* st; };
__device__ __forceinline__ XcdBarrier xcd_barrier_post(unsigned* bar, volatile LAS unsigned* st) {
    XcdBarrier b; b.bar = bar; b.x = xb_xcc_id(); b.st = st;
    if (threadIdx.x == 0) (void)xb_add(&bar[XB_XCNT(b.x)], 1u);
    return b;
}
__device__ __forceinline__ void xcd_barrier_complete(unsigned* bar, unsigned x, unsigned& nloc, unsigned& nx) {
    const unsigned G = gridDim.x * gridDim.y * gridDim.z;
    unsigned sum, cnt, mine, sp = 0u;
    for (;;) {
        sum = 0u; cnt = 0u; mine = 0u;
#pragma unroll
        for (unsigned j = 0; j < 16; ++j) { const unsigned c = xb_ld(&bar[XB_XCNT(j)]); sum += c; cnt += (c > 0u) ? 1u : 0u; mine = (j == x) ? c : mine; }
        if (sum == G) break;
        __builtin_amdgcn_s_sleep(1);
        if ((++sp & 255u) == 0u) { if (xb_ld(&bar[XB_TMO])) break; if (sp > XB_SPIN_CAP) { atomicAdd(&bar[XB_TMO], 1u); break; } }
    }
    nloc = mine > 0u ? mine : 1u; nx = cnt > 0u ? cnt : 1u;
}
__device__ __forceinline__ void xcd_barrier(const XcdBarrier& b) {
    asm volatile("s_waitcnt vmcnt(0)" ::: "memory");
    __syncthreads();
    if (threadIdx.x == 0) {
        unsigned* bar = b.bar;
        __builtin_amdgcn_s_waitcnt(0);
        unsigned nloc = b.st[0], nx = b.st[1];
        if (nloc == 0u) { xcd_barrier_complete(bar, b.x, nloc, nx); b.st[0] = nloc; b.st[1] = nx; }
        const unsigned old = xb_add(&bar[XB_XSUB(b.x)], 1u);
        const unsigned gen = old / nloc;
        if (old + 1u == (gen + 1u) * nloc) {
            __builtin_amdgcn_fence(__ATOMIC_RELEASE, "agent");
            asm volatile("s_waitcnt vmcnt(0)" ::: "memory");
            const unsigned og = xb_add(&bar[XB_TOP], 1u);
            const unsigned tg = og / nx;
            if (og + 1u == (tg + 1u) * nx) xb_add(&bar[XB_TOPGEN], 1u);
            else XB_SPIN(xb_ld(&bar[XB_TOPGEN]) == tg, bar);
            __builtin_amdgcn_fence(__ATOMIC_ACQUIRE, "agent");
            xb_add(&bar[XB_XGEN(b.x)], 1u);
            asm volatile("s_waitcnt vmcnt(0)" ::: "memory");
        } else {
            XB_SPIN(xb_ld(&bar[XB_XGEN(b.x)]) == gen, bar);
            __builtin_amdgcn_fence(__ATOMIC_ACQUIRE, "agent");
            asm volatile("s_waitcnt vmcnt(0)" ::: "memory");
        }
    }
    __syncthreads();
}

constexpr int DBG_NS = 4096, DBG_SLOTS = 16;
__host__ __device__ __forceinline__ void dbg_rc(int i, int nrows, int& r, int& c) {
    const unsigned h = (unsigned)i * 2654435761u;
    c = (int)((h >> 9) & 1023u);
    if (i < 64) { const int sp[8] = {0, 1, 2, 8192, 8193, 32768, 32783, 32767}; r = sp[i & 7] % nrows; }
    else r = (int)(((unsigned)i * 40503u + (h >> 20)) % (unsigned)nrows);
}
__device__ __forceinline__ void dbg_sample_bf16(const Frame& F, int slot, const bf16_t* buf, int nrows) {
    float* dg = (float*)(F.ws + WS_DIGEST) + (size_t)slot * DBG_NS;
    for (int i = F.bid * 512 + F.tid; i < DBG_NS; i += F.G * 512) { int r, c; dbg_rc(i, nrows, r, c); dg[i] = bf1(buf[(size_t)r * D + c]); }
}
__device__ __forceinline__ void dbg_sample_c(const Frame& F, int slot, const bf16_t* cbuf, int nrows = NTOK) {
    float* dg = (float*)(F.ws + WS_DIGEST) + (size_t)slot * DBG_NS;
    for (int i = F.bid * 512 + F.tid; i < DBG_NS; i += F.G * 512) { int r, c; dbg_rc(i, nrows, r, c); dg[i] = bf1(cbuf[(size_t)(2 * r + (i & 1)) * D + c]); }
}
__device__ __forceinline__ void dbg_sample_gate(const Frame& F, int slot, int nrows = NTOK) {
    float* dg = (float*)(F.ws + WS_DIGEST) + (size_t)slot * DBG_NS; const float* tg = (const float*)(F.ws + WS_TOKGATE);
    for (int i = F.bid * 512 + F.tid; i < DBG_NS; i += F.G * 512) { int r, c; dbg_rc(i, nrows, r, c); dg[i] = tg[2 * r + (i & 1)]; }
}

#ifndef MK_SKEW_NS
#define MK_SKEW_NS 0
#endif
__device__ __forceinline__ void gemm_skew(const Frame& F) {
    if (MK_SKEW_NS > 0) { const unsigned long long t0 = __builtin_amdgcn_s_memrealtime(); const unsigned long long d = (unsigned long long)((F.bid >> 6) & 3) * (MK_SKEW_NS / 10);
        while (__builtin_amdgcn_s_memrealtime() - t0 < d) __builtin_amdgcn_s_sleep(4); }
}
__global__ void __launch_bounds__(512, 2) mk_fwd(Args args) {
    extern __shared__ __attribute__((aligned(16))) unsigned char lds_raw[];
    Frame F;
    F.lds = (LAS unsigned char*)lds_raw;
    F.tid = threadIdx.x; F.lane = F.tid & 63; F.wave = __builtin_amdgcn_readfirstlane(F.tid >> 6);
    F.G = gridDim.x; F.bid = blockIdx.x;
    F.ws = args.ws;
    volatile LAS unsigned* MISC = (volatile LAS unsigned*)(F.lds + MISC_OFF);
    if (F.tid < 64) MISC[F.tid] = 0u;
    __syncthreads();
    XcdBarrier bar; bar.bar = (unsigned*)(F.ws + WS_CTL) + CW_BAR; bar.x = 0; bar.st = nullptr;
    if (MK_N_LAUNCHES == 1) bar = xcd_barrier_post((unsigned*)(F.ws + WS_CTL) + CW_BAR, MISC + 8);
    const int lo = args.ph_lo, hi = args.ph_hi;
#ifndef MK_TIME_PHASE
#define MK_TIME_PHASE -1
#endif
    volatile LAS unsigned long long* STAMP = (volatile LAS unsigned long long*)(F.lds + MISC_OFF + 1024);
#define STAMP_AT(k) do { if (MK_TIME_PHASE >= 0 && F.bid == 0 && F.tid == 0) STAMP[k] = __builtin_amdgcn_s_memrealtime(); } while (0)
    STAMP_AT(0);
#define IN(k) (lo <= (k) && (k) < hi)
#ifndef MK_EXTRA_BAR
#define MK_EXTRA_BAR 0
#endif
#define SEAM(k) do { if (IN(k) && IN((k) + 1)) { for (int xb_ = 0; xb_ <= MK_EXTRA_BAR; ++xb_) xcd_barrier(bar); } STAMP_AT((k) + 1); } while (0)
#ifndef MK_REP_MASK
#define MK_REP_MASK 0
#endif
#define REPS(k) for (int rep_ = 0; rep_ < 1 + ((MK_REP_MASK >> (k)) & 1); ++rep_, (void)((rep_ < 1 + ((MK_REP_MASK >> (k)) & 1)) ? (xcd_barrier(bar), 0) : 0))
    bf16_t* RA = WSP(bf16_t, WS_RA); bf16_t* RBb = WSP(bf16_t, WS_RB); bf16_t* RC = WSP(bf16_t, WS_RC); bf16_t* RE = WSP(bf16_t, WS_RE);
    LAS int* tbl = (LAS int*)(F.lds + SMALL_OFF + 1024);

    if (IN(0)) REPS(0) { p0_prologue(F, args); } SEAM(0);
    if (IN(1)) REPS(1) {
        meta_in0(F);
        ProbIn0 P; P.Abase = (const char*)RA; P.ord.init(TREAL / 256, 8, F.G, F.bid); P.Bt = (const char*)(F.ws + WS_WIN0); P.ybr = RBb; P.xraw = RC;
        gemm_skew(F); pg8::gemm_phase(F.lds, P);
    } SEAM(1);
    if (IN(2)) REPS(2) { if (MK_DEBUG_ORACLE) { dbg_sample_bf16(F, 0, RBb, NTOK); dbg_sample_bf16(F, 1, RC, NTOK); } p2_lru<false>(F, args); } SEAM(2);
    if (IN(3)) REPS(3) { p2_lru<true>(F, args); } SEAM(3);
    if (IN(4)) REPS(4) {
        if (MK_DEBUG_ORACLE) dbg_sample_bf16(F, 2, RA, NTOK);
        meta_out0(F, args);
        ProbOut<true> P; P.Abase = (const char*)RA; P.ord.init(TREAL / 256, 4, F.G, F.bid); P.Bt = (const char*)(F.ws + WS_WOUT0); P.y1 = RBb; P.stats = WSP(f32x2, WS_STATS);
        P.x = args.in[0]; P.meta = args.in[1]; P.hres = nullptr;
        gemm_skew(F); pg8::gemm_phase(F.lds, P);
    } SEAM(4);
    if (IN(5)) REPS(5) { if (MK_DEBUG_ORACLE) dbg_sample_bf16(F, 3, RBb, NTOK); p4_ln_route(F, args, 0, RBb, RC); } SEAM(5);
    if (IN(6)) REPS(6) {
        if (MK_DEBUG_ORACLE) { dbg_sample_bf16(F, 4, RC, NTOK); dbg_sample_gate(F, 5); }
        const int total = moe_tables(F, 0);
        ProbUp P; P.Abase = (const char*)RC; P.ord.tbl = tbl; P.ord.c = F.bid; P.ord.total = total; P.gu = (const char*)(F.ws + WS_GU); P.list = WSP(const int, WS_LIST); P.hid = RA; P.mcnt = WSP(unsigned, WS_CTL) + CW_MOE;
        gemm_skew(F); pg8::gemm_phase(F.lds, P);
    }
SEAM(6);
    if (IN(7)) REPS(7) {
        const int total = moe_tables(F, 0);
        ProbDown P; P.Abase = (const char*)RA; P.ord.tbl = tbl; P.ord.c = F.bid; P.ord.total = total; P.dn = (const char*)(F.ws + WS_DN); P.list = WSP(const int, WS_LIST); P.tokgate = WSP(const float, WS_TOKGATE); P.cbuf = RE; P.mcnt = WSP(unsigned, WS_CTL) + CW_MOE; P.tmo = WSP(unsigned, WS_CTL) + CW_TMO;
        gemm_skew(F); pg8::gemm_phase(F.lds, P);
    } SEAM(7);
    if (IN(8)) REPS(8) {
        if (MK_DEBUG_ORACLE) dbg_sample_c(F, 6, RE);
#ifndef MK_SUBREP
#define MK_SUBREP 0
#endif
        for (int sr_ = 0; sr_ < ((MK_SUBREP == 1) ? 2 : 1); ++sr_) p7_combine<false>(F, args, 0, RC, RE, RA, nullptr);
    } SEAM(8);
    if (IN(9)) REPS(9) {
        if (MK_DEBUG_ORACLE) dbg_sample_bf16(F, 7, RA, NTOK);
        meta_in1(F);
        ProbIn1 P; P.Abase = (const char*)RA; P.ord.init(TREAL / 256, 12, F.G, F.bid); P.Bt = (const char*)(F.ws + WS_WIN1); P.bg = RBb; P.z = RC;
#ifndef MK_EPI_PROBE
#define MK_EPI_PROBE 0
#endif
        gemm_skew(F); pg8::gemm_phase(F.lds, P, MK_EPI_PROBE);
    } SEAM(9);
    if (IN(10)) REPS(10) { if (MK_DEBUG_ORACLE) { dbg_sample_bf16(F, 8, RBb, TREAL); dbg_sample_bf16(F, 9, RC, NTOK); } p9_convgate(F, args, RBb, RC, RE); } SEAM(10);
    if (IN(11)) REPS(11) {
        if (MK_DEBUG_ORACLE) dbg_sample_bf16(F, 10, RE, TREAL);
        ProbOut<false> P; P.Abase = (const char*)RE; P.ord.init(TREAL / 256, 4, F.G, F.bid); P.Bt = (const char*)(F.ws + WS_WOUT1); P.y1 = RBb; P.stats = WSP(f32x2, WS_STATS);
        P.x = nullptr; P.meta = nullptr; P.hres = RA;
        gemm_skew(F); pg8::gemm_phase(F.lds, P);
    } SEAM(11);
    if (IN(12)) REPS(12) { if (MK_DEBUG_ORACLE) dbg_sample_bf16(F, 11, RBb, TREAL); p4_ln_route(F, args, 1, RBb, RC); } SEAM(12);
    if (IN(13)) REPS(13) {
        if (MK_DEBUG_ORACLE) { dbg_sample_bf16(F, 12, RC, TREAL); dbg_sample_gate(F, 13, TREAL); }
        const int total = moe_tables(F, 1);
        ProbUp P; P.Abase = (const char*)RC; P.ord.tbl = tbl; P.ord.c = F.bid; P.ord.total = total; P.gu = (const char*)(F.ws + WS_GU1); P.list = WSP(const int, WS_LIST); P.hid = RA; P.mcnt = WSP(unsigned, WS_CTL) + CW_MOE + 32768;
        gemm_skew(F); pg8::gemm_phase(F.lds, P);
    }
SEAM(13);
    if (IN(14)) REPS(14) {
        const int total = moe_tables(F, 1);
        ProbDown P; P.Abase = (const char*)RA; P.ord.tbl = tbl; P.ord.c = F.bid; P.ord.total = total; P.dn = (const char*)(F.ws + WS_DN1); P.list = WSP(const int, WS_LIST); P.tokgate = WSP(const float, WS_TOKGATE); P.cbuf = RE; P.mcnt = WSP(unsigned, WS_CTL) + CW_MOE + 32768; P.tmo = WSP(unsigned, WS_CTL) + CW_TMO;
        gemm_skew(F); pg8::gemm_phase(F.lds, P);
    } SEAM(14);
    if (IN(15)) REPS(15) { if (MK_DEBUG_ORACLE) dbg_sample_c(F, 14, RE, TREAL); p7_combine<true>(F, args, 1, RC, RE, nullptr, args.out); }
    if (MK_TIME_PHASE >= 0 && F.bid == 0 && F.tid == 0) {
        STAMP[16] = __builtin_amdgcn_s_memrealtime();
        const unsigned long long T = MK_EPI_PROBE ? STAMP[20] : (STAMP[MK_TIME_PHASE + 1] - STAMP[MK_TIME_PHASE]);
        const unsigned long long t0 = __builtin_amdgcn_s_memrealtime();
        while (__builtin_amdgcn_s_memrealtime() - t0 < 4ull * T) __builtin_amdgcn_s_sleep(8);
    }
#undef IN
#undef SEAM
}
#if MK_DEBUG_ORACLE
static void dbg_oracle(void* const* d_in, void* d_out, void* d_ws, hipStream_t st);
#endif
extern "C" void kernel_launch(void* const* d_in, const int* in_sizes, int n_in, void* d_out, int out_size, void* d_ws, size_t ws_size, hipStream_t stream) {
    static int grid = 0;
    if (grid == 0) {
        int dev = 0, cus = 0;
        if (hipGetDevice(&dev) != hipSuccess || hipDeviceGetAttribute(&cus, hipDeviceAttributeMultiprocessorCount, dev) != hipSuccess) { fprintf(stderr, "kernel_launch: device query failed\n"); grid = -1; return; }
        if (hipFuncSetAttribute((const void*)mk_fwd, hipFuncAttributeMaxDynamicSharedMemorySize, LDS_BYTES) != hipSuccess) { fprintf(stderr, "kernel_launch: hipFuncSetAttribute failed\n"); grid = -1; return; }
        int per_cu = 0;
        if (hipOccupancyMaxActiveBlocksPerMultiprocessor(&per_cu, (const void*)mk_fwd, 512, LDS_BYTES) != hipSuccess || per_cu < 1) fprintf(stderr, "kernel_launch: occupancy query reports %d blocks per CU\n", per_cu);
        (void)hipGetLastError();
        grid = cus;
        if (n_in != 23 || ws_size < WS_END2) fprintf(stderr, "kernel_launch: unexpected n_in %d / ws_size %zu (need %zu)\n", n_in, ws_size, (size_t)WS_END2);
    }
    if (grid < 0) return;
    (void)hipMemsetAsync((char*)d_ws + WS_CTL, 0, CTL_ZERO_BYTES, stream);
    Args a{};
    for (int i = 0; i < 23; ++i) a.in[i] = (const float*)d_in[i];
    a.out = (float*)d_out; a.ws = (unsigned char*)d_ws;
    if (MK_N_LAUNCHES == 1) {
        a.ph_lo = 0; a.ph_hi = 16;
        hipLaunchKernelGGL(mk_fwd, dim3(grid), dim3(512), LDS_BYTES, stream, a);
    } else {
        for (int p = 0; p < 16; ++p) { a.ph_lo = p; a.ph_hi = p + 1; hipLaunchKernelGGL(mk_fwd, dim3(grid), dim3(512), LDS_BYTES, stream, a); }
    }
#if MK_DEBUG_ORACLE
    dbg_oracle(d_in, d_out, d_ws, stream);
#endif
}
```

```cpp
#include <hip/hip_runtime.h>
#include <cstdio>
#include <cstdint>

#ifndef MK_N_LAUNCHES
#define MK_N_LAUNCHES 1
#endif
#ifndef MK_DEBUG_ORACLE
#define MK_DEBUG_ORACLE 0
#endif

#define GAS __attribute__((address_space(1)))
#define LAS __attribute__((address_space(3)))
typedef unsigned short bf16_t;
typedef short bf16x8 __attribute__((ext_vector_type(8)));
typedef float f32x4 __attribute__((ext_vector_type(4)));
typedef float f32x2 __attribute__((ext_vector_type(2)));
typedef unsigned u32x4 __attribute__((ext_vector_type(4)));
typedef unsigned u32x2 __attribute__((ext_vector_type(2)));
typedef GAS unsigned gu32;

constexpr int D = 1024, NB = 4, SEQ = 8192, NMETA = 16;
constexpr int TREAL = NB * SEQ;
constexpr int NTOK = TREAL + NMETA;
constexpr int R = 33024;
constexpr int NE = 32, NG = 4, DE = 512;
constexpr int CAP = 32800;
constexpr int MAXMT = 288;
constexpr int HIDROWS = MAXMT * 256 + 256;
constexpr float ALPHA = 1.41421356237309515f;
constexpr float LN_EPS = 1e-5f;
constexpr int NPHASES = 15;

constexpr size_t MiB = 1u << 20;
constexpr size_t WS_CTL = 0, CTL_ZERO_BYTES = 32768;
constexpr size_t WS_LIST = 1 * MiB;
constexpr size_t WS_TOKGATE = 6 * MiB + 128 * 1024;
constexpr size_t WS_STATS = 6 * MiB + 512 * 1024;
constexpr size_t WS_SCANSUM = 5 * MiB + 64 * 1024;
constexpr size_t WS_WRF = 11 * MiB + 256 * 1024;
constexpr size_t WS_WAT = 11 * MiB + 512 * 1024;
constexpr size_t WS_WIN0 = 12 * MiB;
constexpr size_t WS_WOUT0 = 16 * MiB;
constexpr size_t WS_WIN1 = 18 * MiB;
constexpr size_t WS_WOUT1 = 24 * MiB;
constexpr size_t WS_GU = 26 * MiB;
constexpr size_t WS_DN = 90 * MiB;
constexpr size_t RB_BYTES = (size_t)R * D * 2;
constexpr size_t WS_RA = 122 * MiB;
constexpr size_t WS_RB = WS_RA + RB_BYTES;
constexpr size_t WS_RC = WS_RB + RB_BYTES;
constexpr size_t WS_RE = WS_RC + RB_BYTES;
constexpr size_t WS_END = WS_RE + 2 * RB_BYTES;
static_assert((size_t)HIDROWS * DE * 2 <= 2 * RB_BYTES, "HID fits RA+RB");
static_assert(WS_STATS + (size_t)R * 16 * 8 <= WS_WRF && WS_LIST + (size_t)NE * CAP * 4 <= WS_SCANSUM && WS_SCANSUM + (1u << 20) <= WS_TOKGATE && WS_TOKGATE + (size_t)2 * R * 4 <= WS_STATS, "small buffers");
constexpr size_t WS_GU1 = WS_END;
constexpr size_t WS_DN1 = WS_GU1 + 64 * MiB;
constexpr size_t WS_END2 = WS_DN1 + 32 * MiB;
constexpr size_t WS_DIGEST = WS_END2;
constexpr int CW_CNT = 64;
constexpr int CW_DBG = 256;
constexpr int CW_BAR = 4096;
constexpr int CW_MOE = 32768;
constexpr int CW_TMO = 16;

constexpr int RING_BYTES = 131072;
constexpr int SMALL_OFF = RING_BYTES;
constexpr int MISC_OFF = 160 * 1024 - 2048;
constexpr int LDS_BYTES = 160 * 1024;

#define RLX_AGENT __ATOMIC_RELAXED, __HIP_MEMORY_SCOPE_AGENT
#define LDS_WAIT() asm volatile("s_waitcnt lgkmcnt(0)" ::: "memory")
#define VM_WAIT() asm volatile("s_waitcnt vmcnt(0)" ::: "memory")

__device__ __forceinline__ unsigned cvt_pk_bf16(float lo, float hi) { unsigned r; asm volatile("v_cvt_pk_bf16_f32 %0, %1, %2" : "=v"(r) : "v"(lo), "v"(hi)); return r; }
__device__ __forceinline__ float bf_lo(unsigned w) { return __builtin_bit_cast(float, w << 16); }
__device__ __forceinline__ float bf_hi(unsigned w) { return __builtin_bit_cast(float, w & 0xffff0000u); }
__device__ __forceinline__ float bf1(unsigned short h) { return __builtin_bit_cast(float, ((unsigned)h) << 16); }
__device__ __forceinline__ void unpack8(const u32x4 w, float (&f)[8]) {
    f[0] = bf_lo(w.x); f[1] = bf_hi(w.x); f[2] = bf_lo(w.y); f[3] = bf_hi(w.y); f[4] = bf_lo(w.z); f[5] = bf_hi(w.z); f[6] = bf_lo(w.w); f[7] = bf_hi(w.w);
}
__device__ __forceinline__ u32x4 pack8(const float (&f)[8]) {
    u32x4 w; w.x = cvt_pk_bf16(f[0], f[1]); w.y = cvt_pk_bf16(f[2], f[3]); w.z = cvt_pk_bf16(f[4], f[5]); w.w = cvt_pk_bf16(f[6], f[7]); return w;
}
__device__ __forceinline__ float fast_sigmoid(float x) { return __builtin_amdgcn_rcpf(1.0f + __builtin_amdgcn_exp2f(-1.44269504089f * x)); }
__device__ __forceinline__ float gelu_tanh_f(float x) {
    const float z2 = 1.5957691216f * (x + 0.044715f * x * x * x);
    return x * fast_sigmoid(z2);
}
__device__ __forceinline__ float wave_sum(float v) {
#pragma unroll
    for (int o = 1; o < 64; o <<= 1) v += __shfl_xor(v, o);
    return v;
}
namespace pg8 {
constexpr int BM = 256, BK = 64, HALF = 128, HTB = HALF * BK * 2  , STAGE_BYTES = 8 * HTB, NXCD = 8, WGM = 8;
__host__ __device__ __forceinline__ int lds_byte(int r, int c) { const int st = (r >> 4) * 2 + (c >> 5), rr = r & 15, cc = c & 31, ob = rr * 64 + cc * 2; return st * 1024 + (ob ^ (((ob >> 9) & 1) << 5)); }
__host__ __device__ __forceinline__ void stage_rc(int b, int& R_, int& C_) { const int st = b / 1024, sb = b % 1024, swz = sb ^ (((sb >> 9) & 1) << 5); R_ = (st >> 1) * 16 + swz / 64; C_ = (st & 1) * 32 + (swz % 64) / 2; }
__host__ __device__ __forceinline__ int perm32(int rho) { const int n = rho >> 4, i = rho & 15; return 8 * (i >> 2) + 4 * n + (i & 3); }

struct Unit { int pm, pn, e, lt, hf; };

struct DenseOrder {
    int nM, nN, nwg, G, c;
    __device__ __forceinline__ void init(int nM_, int nN_, int G_, int c_) { nM = nM_; nN = nN_; nwg = nM * nN; G = G_; c = c_; }
    __device__ __forceinline__ bool next(int i, Unit& u) const {
        const long L = (long)i * G + c; if (L >= nwg) return false;
        int wgid = (int)L; { const int q = nwg / NXCD, r = nwg % NXCD, xcd = wgid % NXCD, off = wgid / NXCD; wgid = (xcd < r ? xcd * (q + 1) : r * (q + 1) + (xcd - r) * q) + off; }
        const int nig = WGM * nN, gid = wgid / nig, fm = gid * WGM, gsz = (nM - fm) < WGM ? (nM - fm) : WGM;
        u.pm = fm + ((wgid % nig) % gsz); u.pn = (wgid % nig) / gsz; u.e = 0; u.lt = 0; u.hf = 0; return true;
    }
};

template <class P>
__device__ __forceinline__ void gemm_phase(LAS unsigned char* lds, const P& prob, int probe = 0) {
    constexpr bool ALIGN_EPI = true;
    const int tid = threadIdx.x, wid = __builtin_amdgcn_readfirstlane(tid >> 6), lane = tid & 63, wr = wid >> 2, wc = wid & 3, fr = lane & 15, fq = lane >> 4;
    constexpr int K = P::K, nt = K / BK;
    int R0, C0; stage_rc(tid * 16, R0, C0);
    unsigned voffB[2];
#pragma unroll
    for (int i = 0; i < 2; ++i) { const int Rr = R0 + 64 * i; const int Rb = (Rr & ~31) + perm32(Rr & 31); voffB[i] = (unsigned)(Rb * K + C0) * 2u; }
    unsigned voffA[2][2];
    constexpr size_t kstep = (size_t)(BK * 2);
    constexpr size_t hstepB = (size_t)HALF * K * 2;
    const unsigned ldsw = (unsigned)wid * 1024u;
    const int aoff = lds_byte(wr * 64 + fr, fq * 8), boff = lds_byte(wc * 32 + fr, fq * 8);
#define PG8_SA(b, h) (((b) * 2 + (h)) * HTB)
#define PG8_SB(b, h) ((4 + (b) * 2 + (h)) * HTB)
#define PG8_STAGE(bufoff, gbase, voff) do { _Pragma("unroll") for (int _i = 0; _i < 2; ++_i) \
        __builtin_amdgcn_global_load_lds((const unsigned*)((const char*)(gbase) + (voff)[_i]), (LAS unsigned*)(lds + (bufoff) + ldsw + _i * 8192), 16, 0, 0); } while (0)
#define PG8_STAGE_A(bufoff, gbase, h) do { _Pragma("unroll") for (int _i = 0; _i < 2; ++_i) { const unsigned _va = P::GATHER ? voffA[h][_i] : (voffA[0][0] + (unsigned)(((h) * 128 + _i * 64) * K * 2)); \
        __builtin_amdgcn_global_load_lds((const unsigned*)((const char*)(gbase) + _va), (LAS unsigned*)(lds + (bufoff) + ldsw + _i * 8192), 16, 0, P::A_AUX); } } while (0)
#define PG8_LDA(dst, b, h) do { _Pragma("unroll") for (int m = 0; m < 4; ++m) _Pragma("unroll") for (int k = 0; k < 2; ++k) dst[m][k] = *(const LAS bf16x8*)(lds + PG8_SA(b, h) + aoff + m * 2048 + k * 1024); } while (0)
#define PG8_LDB(dst, b, h) do { _Pragma("unroll") for (int n = 0; n < 2; ++n) _Pragma("unroll") for (int k = 0; k < 2; ++k) dst[n][k] = *(const LAS bf16x8*)(lds + PG8_SB(b, h) + boff + n * 2048 + k * 1024); } while (0)
#define PG8_MMA(ai, bj, At, Bt) do { __builtin_amdgcn_s_setprio(1); _Pragma("unroll") for (int m = 0; m < 4; ++m) _Pragma("unroll") for (int n = 0; n < 2; ++n) _Pragma("unroll") for (int k = 0; k < 2; ++k) \
        acc[ai][bj][m][n] = __builtin_amdgcn_mfma_f32_16x16x32_bf16(Bt[n][k], At[m][k], acc[ai][bj][m][n], 0, 0, 0); __builtin_amdgcn_s_setprio(0); } while (0)
#define PG8_WAIT_V(n) asm volatile("s_waitcnt vmcnt(" #n ")" ::: "memory")
#define PG8_WAIT_L(n) asm volatile("s_waitcnt lgkmcnt(" #n ")" ::: "memory")
#define PG8_BAR __builtin_amdgcn_s_barrier()
#define PG8_SCHED __builtin_amdgcn_sched_barrier(0)
    Unit cur, nxt, prv; int ui = 0; bool have_prv = false;
    unsigned long long pr_sum = 0, pr_t0 = 0; const bool pr_on = (probe != 0) && blockIdx.x == 0 && wid == 0;
    if (!prob.next(0, cur)) return;
    f32x4 acc[2][2][4][2];
#pragma unroll
    for (int a = 0; a < 2; ++a)
#pragma unroll
        for (int b = 0; b < 2; ++b)
#pragma unroll
            for (int m = 0; m < 4; ++m)
#pragma unroll
                for (int n = 0; n < 2; ++n) acc[a][b][m][n] = (f32x4){0.f, 0.f, 0.f, 0.f};
    bf16x8 At[4][2], B0[2][2], B1[2][2];
    const char* const Ab = prob.Abase;
    const char* cB = prob.b_ptr(cur);
    prob.a_ready(cur);
    prob.a_off(cur, R0, C0 * 2, voffA);
    PG8_STAGE(PG8_SB(0, 0), cB, voffB); PG8_STAGE(PG8_SB(0, 1), cB + hstepB, voffB); PG8_STAGE_A(PG8_SA(0, 0), Ab, 0); PG8_STAGE_A(PG8_SA(0, 1), Ab, 1);
    if (wr == 1) PG8_BAR;
    PG8_WAIT_V(2); PG8_BAR;
    PG8_STAGE(PG8_SB(1, 0), cB + kstep, voffB); PG8_STAGE_A(PG8_SA(1, 0), Ab + kstep, 0); PG8_STAGE(PG8_SB(1, 1), cB + hstepB + kstep, voffB);
    PG8_WAIT_V(6); PG8_BAR;
    for (;;) {
        const bool has_next = prob.next(ui + 1, nxt);
        const char* nB = has_next ? prob.b_ptr(nxt) : cB;
#pragma nounroll
        for (int t = 0; t < nt; t += 2) {
            const bool last = (t == nt - 2);
            const char* a1 = Ab + (size_t)(t + 1) * kstep;
            const char* a2 = last ? Ab : Ab + (size_t)(t + 2) * kstep; const char* b2 = last ? nB : cB + (size_t)(t + 2) * kstep;
            const char* a3 = a2 + kstep; const char* b3 = b2 + kstep;
            if (last && has_next) prob.a_ready(nxt);
            if (pr_on && probe == 2 && t == 0) pr_t0 = __builtin_amdgcn_s_memrealtime();
            PG8_LDB(B0, 0, 0); PG8_LDB(B1, 0, 1); PG8_SCHED; PG8_LDA(At, 0, 0); PG8_STAGE_A(PG8_SA(1, 1), a1, 1);
            if (last && has_next) prob.a_off(nxt, R0, C0 * 2, voffA);
            PG8_WAIT_V(8); PG8_WAIT_L(0); PG8_BAR; if (pr_on && probe == 2 && t == 0) pr_sum += __builtin_amdgcn_s_memrealtime() - pr_t0; PG8_MMA(0, 0, At, B0); PG8_MMA(0, 1, At, B1); PG8_BAR; PG8_SCHED;
            PG8_LDA(At, 0, 1); PG8_STAGE(PG8_SB(0, 0), b2, voffB); PG8_STAGE(PG8_SB(0, 1), b2 + hstepB, voffB); PG8_STAGE_A(PG8_SA(0, 0), a2, 0);
            PG8_WAIT_V(8); PG8_WAIT_L(0); PG8_BAR; if (cur.hf == 0) { PG8_MMA(1, 0, At, B0); PG8_MMA(1, 1, At, B1); } PG8_BAR; PG8_SCHED;
            PG8_LDB(B0, 1, 0); PG8_LDB(B1, 1, 1); PG8_SCHED; PG8_LDA(At, 1, 0); PG8_STAGE_A(PG8_SA(0, 1), a2, 1);
            PG8_WAIT_V(8); PG8_WAIT_L(0); PG8_BAR; PG8_MMA(0, 0, At, B0); PG8_MMA(0, 1, At, B1); PG8_BAR; PG8_SCHED;
            PG8_LDA(At, 1, 1); PG8_STAGE(PG8_SB(1, 0), b3, voffB); PG8_STAGE(PG8_SB(1, 1), b3 + hstepB, voffB); PG8_STAGE_A(PG8_SA(1, 0), a3, 0);
            PG8_WAIT_V(8); PG8_WAIT_L(0); PG8_BAR; if (cur.hf == 0) { PG8_MMA(1, 0, At, B0); PG8_MMA(1, 1, At, B1); } PG8_BAR; PG8_SCHED;
        }
        if (pr_on && probe == 1) pr_t0 = __builtin_amdgcn_s_memrealtime();
        if constexpr (ALIGN_EPI) { if (wr == 0) PG8_BAR; }
        if (have_prv) prob.done(prv);
        prob.epi(acc, cur, wr, wc, fr, fq);
        prv = cur; have_prv = true;
        if (!has_next) break;
#pragma unroll
        for (int a = 0; a < 2; ++a)
#pragma unroll
            for (int b = 0; b < 2; ++b)
#pragma unroll
                for (int m = 0; m < 4; ++m)
#pragma unroll
                    for (int n = 0; n < 2; ++n) acc[a][b][m][n] = (f32x4){0.f, 0.f, 0.f, 0.f};
        cur = nxt; cB = nB; ++ui;
        if constexpr (ALIGN_EPI) { if (wr == 1) PG8_BAR; }
        if (pr_on && probe == 1) pr_sum += __builtin_amdgcn_s_memrealtime() - pr_t0;
    }
    if (pr_on && (threadIdx.x & 63) == 0) *(volatile LAS unsigned long long*)(lds + MISC_OFF + 1024 + 8 * 20) = pr_sum;
    PG8_WAIT_V(0);
    prob.done(prv);
    if constexpr (!ALIGN_EPI) { if (wr == 0) PG8_BAR; }
    PG8_BAR;
#undef PG8_SA
#undef PG8_SB
#undef PG8_STAGE
#undef PG8_STAGE_A
#undef PG8_LDA
#undef PG8_LDB
#undef PG8_MMA
#undef PG8_WAIT_V
#undef PG8_WAIT_L
#undef PG8_BAR
#undef PG8_SCHED
}
}
using pg8::Unit;
typedef f32x4 acc_t[2][2][4][2];

struct DenseA {
    static constexpr bool GATHER = false; static constexpr int A_AUX = 0;
    const char* Abase; pg8::DenseOrder ord;
    __device__ __forceinline__ bool next(int i, Unit& u) const { return ord.next(i, u); }
    __device__ __forceinline__ void a_ready(const Unit&) const {}
    __device__ __forceinline__ void done(const Unit&) const {}
    template <int K> __device__ __forceinline__ void a_off_k(const Unit& u, int R0, int C2, unsigned (&vo)[2][2]) const {
#pragma unroll
        for (int h = 0; h < 2; ++h)
#pragma unroll
            for (int i = 0; i < 2; ++i) vo[h][i] = (unsigned)((u.pm * 256 + h * 128 + R0 + 64 * i) * K * 2 + C2);
    }
};

struct ProbIn0 : DenseA {
    static constexpr int K = 1024;
    const char* Bt; bf16_t* ybr; bf16_t* xraw;
    __device__ __forceinline__ void a_off(const Unit& u, int R0, int C2, unsigned (&vo)[2][2]) const { a_off_k<K>(u, R0, C2, vo); }
    __device__ __forceinline__ const char* b_ptr(const Unit& u) const { return Bt + (size_t)u.pn * 256 * K * 2; }
    __device__ __forceinline__ void epi(const acc_t& acc, const Unit& u, int wr, int wc, int fr, int fq) const {
        const bool left = u.pn < 4;
        bf16_t* base = left ? ybr : xraw;
        const int col0 = (u.pn & 3) * 256 + wc * 32 + 8 * fq, row0 = u.pm * 256 + wr * 64 + fr;
#pragma unroll
        for (int ai = 0; ai < 2; ++ai)
#pragma unroll
            for (int m = 0; m < 4; ++m) { bf16_t* rowp = base + (size_t)(row0 + ai * 128 + m * 16) * D + col0;
#pragma unroll
                for (int bj = 0; bj < 2; ++bj) { f32x4 v0 = acc[ai][bj][m][0], v1 = acc[ai][bj][m][1];
                    if (left) {
#pragma unroll
                        for (int j = 0; j < 4; ++j) { v0[j] = gelu_tanh_f(v0[j]); v1[j] = gelu_tanh_f(v1[j]); } }
                    u32x4 w; w.x = cvt_pk_bf16(v0[0], v0[1]); w.y = cvt_pk_bf16(v0[2], v0[3]); w.z = cvt_pk_bf16(v1[0], v1[1]); w.w = cvt_pk_bf16(v1[2], v1[3]);
                    *(u32x4*)(rowp + bj * 128) = w; } }
    }
};

template <bool RES_F32> struct ProbOut : DenseA {
    static constexpr int K = 1024;
    const char* Bt; bf16_t* y1; f32x2* stats;
    const float* x; const float* meta;
    const bf16_t* hres;
    __device__ __forceinline__ void a_off(const Unit& u, int R0, int C2, unsigned (&vo)[2][2]) const { a_off_k<K>(u, R0, C2, vo); }
    __device__ __forceinline__ const char* b_ptr(const Unit& u) const { return Bt + (size_t)u.pn * 256 * K * 2; }
    __device__ __forceinline__ void epi(const acc_t& acc, const Unit& u, int wr, int wc, int fr, int fq) const {
        const int col0 = u.pn * 256 + wc * 32 + 8 * fq, row0 = u.pm * 256 + wr * 64 + fr;
#pragma unroll
        for (int ai = 0; ai < 2; ++ai) {
            f32x4 rf[4][2][2]; u32x4 rh[4][2]; float al[4];
#pragma unroll
            for (int m = 0; m < 4; ++m) {
                const int row = row0 + ai * 128 + m * 16;
                if (RES_F32) { const int rc = row < NTOK ? row : NTOK - 1; const float* rp = ((rc < TREAL) ? (x + (size_t)rc * D) : (meta + (size_t)(rc - TREAL) * D)) + col0; al[m] = row < NTOK ? ALPHA : 0.f;
#pragma unroll
                    for (int bj = 0; bj < 2; ++bj) { rf[m][bj][0] = *(const f32x4*)(rp + bj * 128); rf[m][bj][1] = *(const f32x4*)(rp + bj * 128 + 4); } }
                else { const bf16_t* hp = hres + (size_t)row * D + col0; al[m] = ALPHA;
#pragma unroll
                    for (int bj = 0; bj < 2; ++bj) rh[m][bj] = *(const u32x4*)(hp + bj * 128); }
            }
#pragma unroll
            for (int m = 0; m < 4; ++m) {
                const int row = row0 + ai * 128 + m * 16;
                float s1 = 0.f, s2 = 0.f;
                bf16_t* rowp = y1 + (size_t)row * D + col0;
#pragma unroll
                for (int bj = 0; bj < 2; ++bj) {
                    float r8[8];
                    if (RES_F32) { const f32x4 a = rf[m][bj][0], b = rf[m][bj][1]; r8[0] = a[0]; r8[1] = a[1]; r8[2] = a[2]; r8[3] = a[3]; r8[4] = b[0]; r8[5] = b[1]; r8[6] = b[2]; r8[7] = b[3]; }
                    else unpack8(rh[m][bj], r8);
                    float v[8];
#pragma unroll
                    for (int j = 0; j < 4; ++j) { v[j] = acc[ai][bj][m][0][j] + al[m] * r8[j]; v[4 + j] = acc[ai][bj][m][1][j] + al[m] * r8[4 + j]; }
#pragma unroll
                    for (int j = 0; j < 8; ++j) { s1 += v[j]; s2 += v[j] * v[j]; }
                    __builtin_nontemporal_store(pack8(v), (u32x4*)(rowp + bj * 128));
                }
                s1 += __shfl_xor(s1, 16); s1 += __shfl_xor(s1, 32); s2 += __shfl_xor(s2, 16); s2 += __shfl_xor(s2, 32);
                if (fq == 0) stats[(size_t)row * 16 + u.pn * 4 + wc] = (f32x2){s1, s2};
            }
        }
    }
};

struct ProbIn1 : DenseA {
    static constexpr int K = 1024;
    const char* Bt; bf16_t* bg; bf16_t* z;
    __device__ __forceinline__ void a_off(const Unit& u, int R0, int C2, unsigned (&vo)[2][2]) const { a_off_k<K>(u, R0, C2, vo); }
    __device__ __forceinline__ const char* b_ptr(const Unit& u) const { return Bt + (size_t)u.pn * 256 * K * 2; }
    __device__ __forceinline__ void epi(const acc_t& acc, const Unit& u, int wr, int wc, int fr, int fq) const {
        const int row0 = u.pm * 256 + wr * 64 + fr;
        if (u.pn < 4) {
            const int col0 = u.pn * 256 + wc * 32 + 8 * fq;
#pragma unroll
            for (int ai = 0; ai < 2; ++ai)
#pragma unroll
                for (int m = 0; m < 4; ++m) { bf16_t* rowp = bg + (size_t)(row0 + ai * 128 + m * 16) * D + col0;
#pragma unroll
                    for (int bj = 0; bj < 2; ++bj) { const f32x4 v0 = acc[ai][bj][m][0], v1 = acc[ai][bj][m][1];
                        u32x4 w; w.x = cvt_pk_bf16(v0[0], v0[1]); w.y = cvt_pk_bf16(v0[2], v0[3]); w.z = cvt_pk_bf16(v1[0], v1[1]); w.w = cvt_pk_bf16(v1[2], v1[3]);
                        *(u32x4*)(rowp + bj * 128) = w; } }
        } else {
            const int col0 = (u.pn - 4) * 128 + wc * 32 + 8 * fq;
#pragma unroll
            for (int ai = 0; ai < 2; ++ai)
#pragma unroll
                for (int m = 0; m < 4; ++m) { bf16_t* rowp = z + (size_t)(row0 + ai * 128 + m * 16) * D + col0;
                    const f32x4 v0 = acc[ai][0][m][0] * acc[ai][1][m][0], v1 = acc[ai][0][m][1] * acc[ai][1][m][1];
                    u32x4 w; w.x = cvt_pk_bf16(v0[0], v0[1]); w.y = cvt_pk_bf16(v0[2], v0[3]); w.z = cvt_pk_bf16(v1[0], v1[1]); w.w = cvt_pk_bf16(v1[2], v1[3]);
                    *(u32x4*)rowp = w; }
        }
    }
};

struct MoeOrder {
    const LAS int* tbl; int c, total;
    __device__ __forceinline__ bool next(int i, Unit& u) const {
        const int off = (c & 7) * 32 + (c >> 3);
        const int nfr = total >> 8, rem = total & 255;
        int L = i * 256 + off; u.hf = 0;
        if (rem > 0 && rem <= 128 && i == nfr) {
            if (off >= 2 * rem) return false;
            L = nfr * 256 + (off >> 1); u.hf = 1 + (off & 1);
        } else if (L >= total) return false;
        const int mt = L >> 2; u.pn = L & 3; u.pm = mt;
        int e = 0;
#pragma unroll 1
        for (int j = 1; j < NE; ++j) if (tbl[32 + j] <= mt) e = j;
        u.e = e; u.lt = mt - tbl[32 + e];
        return true;
    }
};

struct ProbUp {
    static constexpr int K = 1024; static constexpr bool GATHER = true; static constexpr int A_AUX = 0;
    const char* Abase; MoeOrder ord; const char* gu; const int* list; bf16_t* hid; unsigned* mcnt;
    __device__ __forceinline__ void a_ready(const Unit&) const {}
    __device__ __forceinline__ void done(const Unit&) const {}
    __device__ __forceinline__ bool next(int i, Unit& u) const { return ord.next(i, u); }
    __device__ __forceinline__ void a_off(const Unit& u, int R0, int C2, unsigned (&vo)[2][2]) const {
        const int cnt = ord.tbl[u.e];
#pragma unroll
        for (int h = 0; h < 2; ++h)
#pragma unroll
            for (int i = 0; i < 2; ++i) { const int rank = u.lt * 256 + (u.hf ? (u.hf - 1) * 128 : h * 128) + R0 + 64 * i;
                int tok = R - 1;
                if (rank < cnt) tok = list[u.e * CAP + rank] >> 1;
                vo[h][i] = (unsigned)(tok * (K * 2) + C2); }
    }
    __device__ __forceinline__ const char* b_ptr(const Unit& u) const { return gu + ((size_t)u.e * 1024 + (size_t)u.pn * 256) * K * 2; }
    __device__ __forceinline__ void epi(const acc_t& acc, const Unit& u, int wr, int wc, int fr, int fq) const {
        const int col0 = u.pn * 128 + wc * 32 + 8 * fq, row0 = u.pm * 256 + (u.hf == 2 ? 128 : 0) + wr * 64 + fr;
#pragma unroll
        for (int ai = 0; ai < 2; ++ai) if (ai == 0 || u.hf == 0)
#pragma unroll
            for (int m = 0; m < 4; ++m) { bf16_t* rowp = hid + (size_t)(row0 + ai * 128 + m * 16) * DE + col0;
                float v[8];
#pragma unroll
                for (int j = 0; j < 4; ++j) { const float g0 = acc[ai][0][m][0][j], g1 = acc[ai][0][m][1][j];
                    v[j] = g0 * fast_sigmoid(g0) * acc[ai][1][m][0][j]; v[4 + j] = g1 * fast_sigmoid(g1) * acc[ai][1][m][1][j]; }
                *(u32x4*)rowp = pack8(v); }
    }
};

struct ProbDown {
    static constexpr int K = 512; static constexpr bool GATHER = false; static constexpr int A_AUX = 0;
    const char* Abase; MoeOrder ord; const char* dn; const int* list; const float* tokgate; bf16_t* cbuf; unsigned* mcnt; unsigned* tmo;
    __device__ __forceinline__ void done(const Unit&) const {}
    __device__ __forceinline__ void a_ready(const Unit&) const {}
    __device__ __forceinline__ bool next(int i, Unit& u) const { return ord.next(i, u); }
    __device__ __forceinline__ void a_off(const Unit& u, int R0, int C2, unsigned (&vo)[2][2]) const {
#pragma unroll
        for (int h = 0; h < 2; ++h)
#pragma unroll
            for (int i = 0; i < 2; ++i) vo[h][i] = (unsigned)((u.pm * 256 + (u.hf == 2 ? 128 : 0) + h * 128 + R0 + 64 * i) * K * 2 + C2);
    }
    __device__ __forceinline__ const char* b_ptr(const Unit& u) const { return dn + ((size_t)u.e * 1024 + (size_t)u.pn * 256) * K * 2; }
    __device__ __forceinline__ void epi(const acc_t& acc, const Unit& u, int wr, int wc, int fr, int fq) const {
        const int cnt = ord.tbl[u.e];
        const int col0 = u.pn * 256 + wc * 32 + 8 * fq, rr0 = (u.hf == 2 ? 128 : 0) + wr * 64 + fr;
        int li[8]; float gt[8];
#pragma unroll
        for (int q = 0; q < 8; ++q) { const int rank = u.lt * 256 + rr0 + (q >> 2) * 128 + (q & 3) * 16; li[q] = list[u.e * CAP + (rank < cnt ? rank : 0)]; }
#pragma unroll
        for (int q = 0; q < 8; ++q) gt[q] = tokgate[li[q]];
#pragma unroll
        for (int ai = 0; ai < 2; ++ai)
#pragma unroll
            for (int m = 0; m < 4; ++m) {
                const int rank = u.lt * 256 + rr0 + ai * 128 + m * 16;
                const bool ok = rank < cnt && (ai == 0 || u.hf == 0);
                const float g = gt[ai * 4 + m];
                bf16_t* rowp = cbuf + (size_t)li[ai * 4 + m] * D + col0;
#pragma unroll
                for (int bj = 0; bj < 2; ++bj) { const f32x4 v0 = acc[ai][bj][m][0] * g, v1 = acc[ai][bj][m][1] * g;
                    u32x4 w; w.x = cvt_pk_bf16(v0[0], v0[1]); w.y = cvt_pk_bf16(v0[2], v0[3]); w.z = cvt_pk_bf16(v1[0], v1[1]); w.w = cvt_pk_bf16(v1[2], v1[3]);
                    if (ok) *(u32x4*)(rowp + bj * 128) = w; } }
    }
};
struct Args { const float* in[23]; float* out; unsigned char* ws; int ph_lo, ph_hi; };
struct Frame {
    LAS unsigned char* lds;
    int tid, lane, wave, bid, G;
    unsigned char* ws;
};
#define WSP(T, off) ((T*)(F.ws + (off)))

__device__ __forceinline__ void transpose_item(const float* __restrict__ W, int ldw, int k0, int n0, bf16_t* __restrict__ WT, int ldk, int drow0, LAS float* scr, int lane) {
    f32x4 v[8];
    const float* src = W + (size_t)(k0 + (lane >> 3)) * ldw + n0 + 4 * (lane & 7);
#pragma unroll
    for (int i = 0; i < 8; ++i) v[i] = __builtin_nontemporal_load((const f32x4*)(src + (size_t)(8 * i) * ldw));
#pragma unroll
    for (int i = 0; i < 8; ++i) { LAS float* d = scr + ((lane >> 3) + 8 * i) * 33 + 4 * (lane & 7); d[0] = v[i][0]; d[1] = v[i][1]; d[2] = v[i][2]; d[3] = v[i][3]; }
    LDS_WAIT(); asm volatile("" ::: "memory");
    const int c = lane & 7;
#pragma unroll
    for (int j = 0; j < 4; ++j) { const int n = (lane >> 3) + 8 * j; const LAS float* s = scr + (8 * c) * 33 + n;
        u32x4 o; o.x = cvt_pk_bf16(s[0 * 33], s[1 * 33]); o.y = cvt_pk_bf16(s[2 * 33], s[3 * 33]); o.z = cvt_pk_bf16(s[4 * 33], s[5 * 33]); o.w = cvt_pk_bf16(s[6 * 33], s[7 * 33]);
        *(u32x4*)(WT + (size_t)(drow0 + n) * ldk + k0 + 8 * c) = o; }
    LDS_WAIT(); asm volatile("" ::: "memory");
}
template <int MAP> __device__ __forceinline__ void transpose_dense_item(const float* W, int K, int N, bf16_t* WT, int item, LAS float* scr, int lane) {
    const int nblk = N / 32, kb = item / nblk, nb = item % nblk, n0 = nb * 32;
    int drow = n0;
    if (MAP == 1 && n0 >= 1024) { const int s = (n0 >= 2048) ? 1 : 0, j = n0 - 1024 - 1024 * s; drow = 1024 + 256 * (j >> 7) + 128 * s + (j & 127); }
    transpose_item(W, N, kb * 64, n0, WT, K, drow, scr, lane);
}
__device__ __forceinline__ void tr_issue(const float* __restrict__ W, int ldw, int k0, int n0, f32x4 (&v)[8], int lane) {
    const float* src = W + (size_t)(k0 + (lane >> 3)) * ldw + n0 + 4 * (lane & 7);
#pragma unroll
    for (int i = 0; i < 8; ++i) v[i] = __builtin_nontemporal_load((const f32x4*)(src + (size_t)(8 * i) * ldw));
}
__device__ __forceinline__ void tr_to_lds(const f32x4 (&v)[8], LAS float* scr, int lane) {
#pragma unroll
    for (int i = 0; i < 8; ++i) { LAS float* d = scr + ((lane >> 3) + 8 * i) * 33 + 4 * (lane & 7); d[0] = v[i][0]; d[1] = v[i][1]; d[2] = v[i][2]; d[3] = v[i][3]; }
}
__device__ __forceinline__ void tr_from_lds(bf16_t* __restrict__ WT, int ldk, int drow0, int k0, LAS float* scr, int lane) {
    LDS_WAIT(); asm volatile("" ::: "memory");
    const int c = lane & 7;
#pragma unroll
    for (int j = 0; j < 4; ++j) { const int n = (lane >> 3) + 8 * j; const LAS float* s = scr + (8 * c) * 33 + n;
        u32x4 o; o.x = cvt_pk_bf16(s[0 * 33], s[1 * 33]); o.y = cvt_pk_bf16(s[2 * 33], s[3 * 33]); o.z = cvt_pk_bf16(s[4 * 33], s[5 * 33]); o.w = cvt_pk_bf16(s[6 * 33], s[7 * 33]);
        __builtin_nontemporal_store(o, (u32x4*)(WT + (size_t)(drow0 + n) * ldk + k0 + 8 * c)); }
    LDS_WAIT(); asm volatile("" ::: "memory");
}
__device__ __forceinline__ void tr_finish(const f32x4 (&v)[8], bf16_t* __restrict__ WT, int ldk, int drow0, int k0, LAS float* scr, int lane) { tr_to_lds(v, scr, lane); tr_from_lds(WT, ldk, drow0, k0, scr, lane); }
struct MoeItem { const float* W; bf16_t* WT; int ldw, ldk, k0, n0, drow0; };
constexpr int MOE_IDS = 2 * NE * 768;
constexpr int DN_WOUT0 = 16 * 32, DN_WIN1 = 16 * 96, DN_WOUT1 = 16 * 32;
constexpr int ALL_IDS = MOE_IDS + DN_WOUT0 + DN_WIN1 + DN_WOUT1;
__device__ __forceinline__ MoeItem moe_item(const Frame& F, const Args& A, int id) {
    MoeItem m;
    if (id >= MOE_IDS) {
        int r = id - MOE_IDS; int N; int map = 0;
        if (r < DN_WOUT0) { m.W = A.in[10]; N = D; m.WT = WSP(bf16_t, WS_WOUT0); }
        else if (r < DN_WOUT0 + DN_WIN1) { r -= DN_WOUT0; m.W = A.in[11]; N = 3072; m.WT = WSP(bf16_t, WS_WIN1); map = 1; }
        else { r -= DN_WOUT0 + DN_WIN1; m.W = A.in[13]; N = D; m.WT = WSP(bf16_t, WS_WOUT1); }
        const int nblk = N / 32, kb = r / nblk, nb = r % nblk; m.ldw = N; m.ldk = D; m.k0 = kb * 64; m.n0 = nb * 32; m.drow0 = m.n0;
        if (map == 1 && m.n0 >= 1024) { const int s2 = (m.n0 >= 2048) ? 1 : 0, j = m.n0 - 1024 - 1024 * s2; m.drow0 = 1024 + 256 * (j >> 7) + 128 * s2 + (j & 127); }
        return m;
    }
    const int layer = id / (NE * 768), item = id % (NE * 768);
    const int e = item / 768, r = item % 768, kind = r >> 8, q = r & 255;
    if (kind < 2) {
        m.W = (kind ? A.in[19] : A.in[18]) + ((size_t)layer * NE + e) * D * DE; m.ldw = DE;
        m.k0 = (q >> 4) * 64; m.n0 = (q & 15) * 32; m.WT = WSP(bf16_t, layer ? WS_GU1 : WS_GU) + (size_t)e * 1024 * 1024; m.ldk = D; m.drow0 = 256 * (m.n0 >> 7) + 128 * kind + (m.n0 & 127);
    } else {
        m.W = A.in[20] + ((size_t)layer * NE + e) * DE * D; m.ldw = D;
        m.k0 = (q >> 5) * 64; m.n0 = (q & 31) * 32; m.WT = WSP(bf16_t, layer ? WS_DN1 : WS_DN) + (size_t)e * 1024 * 512; m.ldk = DE; m.drow0 = m.n0;
    }
    return m;
}
__device__ __forceinline__ void p0_prologue(const Frame& F, const Args& A) {
    LAS float* scr = (LAS float*)(F.lds + F.wave * 8448);
    const int gw = F.bid * 8 + F.wave, NGW = F.G * 8;
    const int gt = F.bid * 512 + F.tid, NT = F.G * 512;
    bf16_t* A0 = WSP(bf16_t, WS_RA);
    for (int p0 = gt; p0 < R * 128; p0 += 4 * NT) {
        f32x4 a[4], b[4];
#pragma unroll
        for (int u = 0; u < 4; ++u) { const int p = p0 + u * NT; const int r = p >> 7, c8 = (p & 127) * 8;
            const int rc = r < NTOK ? r : 0;
            const float* src = (rc < TREAL) ? (A.in[0] + (size_t)rc * D) : (A.in[1] + (size_t)(rc - TREAL) * D);
            a[u] = __builtin_nontemporal_load((const f32x4*)(src + c8)); b[u] = __builtin_nontemporal_load((const f32x4*)(src + c8 + 4)); }
#pragma unroll
        for (int u = 0; u < 4; ++u) { const int p = p0 + u * NT; const int r = p >> 7, c8 = (p & 127) * 8;
            u32x4 o; o.x = cvt_pk_bf16(a[u][0], a[u][1]); o.y = cvt_pk_bf16(a[u][2], a[u][3]); o.z = cvt_pk_bf16(b[u][0], b[u][1]); o.w = cvt_pk_bf16(b[u][2], b[u][3]);
            if (r >= NTOK) o = (u32x4){0u, 0u, 0u, 0u};
            if (r < R) *(u32x4*)(A0 + (size_t)r * D + c8) = o; }
    }
    if (F.bid == 0 && F.tid < 128) *(u32x4*)(WSP(bf16_t, WS_RC) + (size_t)(R - 1) * D + F.tid * 8) = (u32x4){0u, 0u, 0u, 0u};
    constexpr int I0 = 16 * 64;
    for (int it = gw; it < I0; it += NGW) transpose_dense_item<0>(A.in[2], D, 2048, WSP(bf16_t, WS_WIN0), it, scr, F.lane);
    bf16_t* wat = WSP(bf16_t, WS_WAT);
    for (int p = gt; p < 2 * 65536; p += NT) {
        const int which = p >> 16, q = p & 65535, hd = q >> 12, e = (q >> 6) & 63, d = q & 63;
        const float v = (which ? A.in[7] : A.in[5])[(hd * 64 + d) * 64 + e];
        wat[p] = (bf16_t)(cvt_pk_bf16(v, 0.f) & 0xffffu);
    }
    bf16_t* wrf = WSP(bf16_t, WS_WRF);
    for (int p = gt; p < 2 * 32 * 3 * 64 * 8; p += NT) {
        const int jj = p & 7, ln = (p >> 3) & 63, sb = (p >> 9) % 96, layer = p / (96 * 512), s = sb / 3, blk = sb % 3;
        const int n = blk * 16 + (ln & 15), k = 32 * s + 8 * (ln >> 4) + jj;
        float v = 0.f;
        if (n < 4) v = A.in[14][((size_t)layer * D + k) * NG + n];
        else if (n >= 16) v = A.in[16][((size_t)layer * D + k) * NE + (n - 16)];
        wrf[p] = (bf16_t)(cvt_pk_bf16(v, 0.f) & 0xffffu);
    }
}

constexpr int P2_WF = 0  , P2_CW = 16384  , P2_WV = 18432, P2_WVB = 8960  , P2_TR = 90112  ;
template <bool APPLY>
__device__ __forceinline__ void p2_lru(const Frame& F, const Args& A) {
    const bf16_t* xraw = WSP(bf16_t, WS_RC); const bf16_t* ybr = WSP(bf16_t, WS_RB); bf16_t* gout = WSP(bf16_t, WS_RA);
    float* scansum = WSP(float, WS_SCANSUM);
    LAS unsigned char* L = F.lds;
    LAS float* cwl = (LAS float*)(L + P2_CW);
    const int tid = F.tid, lane = F.lane, w = F.wave, fr = lane & 15, q = lane >> 4;
    LAS float* XCW = (LAS float*)(L + P2_WV + w * P2_WVB);
    LAS unsigned char* const YBW0 = L + P2_WV + w * P2_WVB + 4352;
    for (int u = F.bid; u < 256; u += F.G) {
        const int b = u >> 6, hd = (u >> 2) & 15, sg = u & 3, rho = sg * 8 + w;
        __syncthreads();
        { const bf16_t* wat = WSP(bf16_t, WS_WAT) + (size_t)hd * 4096;
          for (int p = tid; p < 1024; p += 512) { const int gate = p >> 9, n = (p >> 7) & 3, s2 = (p >> 6) & 1, ln = p & 63;
              *(LAS u32x4*)(L + P2_WF + p * 16) = *(const u32x4*)(wat + gate * 65536 + (16 * n + (ln & 15)) * 64 + 32 * s2 + 8 * (ln >> 4)); } }
        if (tid < 320) { const int k = tid >> 6, c = tid & 63; cwl[tid] = (k < 4) ? A.in[3][k * D + hd * 64 + c] : A.in[4][hd * 64 + c]; }
        float cba[4], cbi[4], csp[4];
#pragma unroll
        for (int n = 0; n < 4; ++n) { const int c = hd * 64 + 16 * n + fr; cba[n] = -1.44269504089f * A.in[6][c]; cbi[n] = -1.44269504089f * A.in[8][c];
            const float nl = -A.in[9][c]; csp[n] = -1.44269504089f * 8.0f * ((nl > 20.f) ? nl : log1pf(expf(nl))); }
        float hin[4] = {0.f, 0.f, 0.f, 0.f}, pin[4] = {1.f, 1.f, 1.f, 1.f};
        if (APPLY) {
#pragma unroll 1
            for (int r2 = 0; r2 < rho; ++r2) { const float* sp = scansum + (((size_t)(b * 16 + hd) * 32 + r2) * 64 + fr) * 2;
#pragma unroll
                for (int n = 0; n < 4; ++n) hin[n] = sp[n * 32] * hin[n] + sp[n * 32 + 1]; }
        }
        __syncthreads();
        const int nsc = (rho == 0) ? 17 : 16;
        const bf16_t* xbase = xraw + hd * 64 + 8 * q; const bf16_t* ybase = ybr + hd * 64 + (lane & 3) * 16;
        u32x4 xv[4][2], yv[2];
        f32x4 tv[8]; int tid_prev = -1;
        LAS float* trscr = (LAS float*)(L + P2_TR + w * 8448);
#define P2_LOAD(sc, XV, YV) do { const bool metac_ = (rho == 0 && (sc) == 0); const int P0_ = metac_ ? 0 : NMETA + rho * 256 + 16 * ((sc) - (rho == 0 ? 1 : 0)); \
            _Pragma("unroll") for (int k = 0; k < 4; ++k) { const int pos = P0_ + fr - 3 + k; \
                const size_t row = (pos < 0) ? (size_t)(R - 1)   : ((pos < NMETA) ? (size_t)(TREAL + pos) : ((size_t)b * SEQ + (pos - NMETA))); \
                XV[k][0] = *(const u32x4*)(xbase + row * D); XV[k][1] = *(const u32x4*)(xbase + row * D + 32); } \
            if (APPLY) { const int pos = P0_ + (lane >> 2); const size_t row = (pos < NMETA) ? (size_t)(TREAL + pos) : ((size_t)b * SEQ + (pos - NMETA)); \
                YV[0] = *(const u32x4*)(ybase + row * D); YV[1] = *(const u32x4*)(ybase + row * D + 8); } } while (0)
        P2_LOAD(0, xv, yv);
#define P2_GSTORE(sc, YB) do { const bool metac_ = (rho == 0 && (sc) == 0); if (!metac_ || b == 0) { \
            const int P0_ = metac_ ? 0 : NMETA + rho * 256 + 16 * ((sc) - (rho == 0 ? 1 : 0)); \
            const int pos = P0_ + (lane >> 2); const size_t row = (pos < NMETA) ? (size_t)(TREAL + pos) : ((size_t)b * SEQ + (pos - NMETA)); \
            bf16_t* gp = gout + row * D + hd * 64 + (lane & 3) * 16; \
            *(u32x4*)gp = *(const LAS u32x4*)((YB) + (lane >> 2) * 144 + ((lane & 3) * 2) * 16); \
            *(u32x4*)(gp + 8) = *(const LAS u32x4*)((YB) + (lane >> 2) * 144 + ((lane & 3) * 2 + 1) * 16); } } while (0)
#pragma unroll 1
        for (int sc = 0; sc < nsc; ++sc) {
            LAS unsigned char* const YBW = YBW0 + (sc & 1) * 2304;
            asm volatile("" ::: "memory");
            { const int idn = (APPLY ? 32768 : 0) + sc * 2048 + u * 8 + w; const int tid_next = (sc < 16 && idn < ALL_IDS) ? idn : -1;
              if (tid_prev >= 0) tr_to_lds(tv, trscr, lane);
              if (tid_next >= 0) { const MoeItem m = moe_item(F, A, tid_next); tr_issue(m.W, m.ldw, m.k0, m.n0, tv, lane); }
              if (tid_prev >= 0) { const MoeItem m = moe_item(F, A, tid_prev); tr_from_lds(m.WT, m.ldk, m.drow0, m.k0, trscr, lane); }
              tid_prev = tid_next; }
            bf16x8 af[2];
#pragma unroll
            for (int s2 = 0; s2 < 2; ++s2) {
                float xc[8];
                { const f32x4 ba = *(const LAS f32x4*)(cwl + 256 + 32 * s2 + 8 * q), bc = *(const LAS f32x4*)(cwl + 256 + 32 * s2 + 8 * q + 4);
#pragma unroll
                  for (int j = 0; j < 4; ++j) { xc[j] = ba[j]; xc[4 + j] = bc[j]; } }
#pragma unroll
                for (int k = 0; k < 4; ++k) { float xf[8]; unpack8(xv[k][s2], xf);
                    const f32x4 wa = *(const LAS f32x4*)(cwl + 64 * k + 32 * s2 + 8 * q), wb = *(const LAS f32x4*)(cwl + 64 * k + 32 * s2 + 8 * q + 4);
#pragma unroll
                    for (int j = 0; j < 4; ++j) { xc[j] += wa[j] * xf[j]; xc[4 + j] += wb[j] * xf[4 + j]; } }
                af[s2] = __builtin_bit_cast(bf16x8, pack8(xc));
                *(LAS f32x4*)(XCW + fr * 68 + 32 * s2 + 8 * q) = (f32x4){xc[0], xc[1], xc[2], xc[3]};
                *(LAS f32x4*)(XCW + fr * 68 + 32 * s2 + 8 * q + 4) = (f32x4){xc[4], xc[5], xc[6], xc[7]};
            }
            if (APPLY) { *(LAS u32x4*)(YBW + (lane >> 2) * 144 + ((lane & 3) * 2) * 16) = yv[0]; *(LAS u32x4*)(YBW + (lane >> 2) * 144 + ((lane & 3) * 2 + 1) * 16) = yv[1]; }
            LDS_WAIT(); asm volatile("" ::: "memory");
            if (sc + 1 < nsc) P2_LOAD(sc + 1, xv, yv);
            if (APPLY && sc > 0) P2_GSTORE(sc - 1, YBW0 + ((sc - 1) & 1) * 2304);
            asm volatile("" ::: "memory");
            float xcv[4][4], ybv[4][4];
#pragma unroll
            for (int n = 0; n < 4; ++n)
#pragma unroll
                for (int j = 0; j < 4; ++j) { xcv[n][j] = XCW[(4 * q + j) * 68 + 16 * n + fr];
                    if (APPLY) ybv[n][j] = bf1(*((const LAS unsigned short*)(YBW + (4 * q + j) * 144) + 16 * n + fr)); }
            float av[4][4], bv[4][4], Ap[4], Bp[4];
#pragma unroll
            for (int n = 0; n < 4; ++n) {
                f32x4 ca = (f32x4){0.f, 0.f, 0.f, 0.f}, ci = ca;
#pragma unroll
                for (int s2 = 0; s2 < 2; ++s2) { const bf16x8 fa = *(const LAS bf16x8*)(L + P2_WF + (((0 * 4 + n) * 2 + s2) * 64 + lane) * 16), fi = *(const LAS bf16x8*)(L + P2_WF + (((1 * 4 + n) * 2 + s2) * 64 + lane) * 16);
                    ca = __builtin_amdgcn_mfma_f32_16x16x32_bf16(af[s2], fa, ca, 0, 0, 0); ci = __builtin_amdgcn_mfma_f32_16x16x32_bf16(af[s2], fi, ci, 0, 0, 0); }
                Ap[n] = 1.f; Bp[n] = 0.f;
#pragma unroll
                for (int j = 0; j < 4; ++j) {
                    const float r = __builtin_amdgcn_rcpf(1.0f + __builtin_amdgcn_exp2f(__builtin_fmaf(ca[j], -1.44269504089f, cba[n])));
                    const float gi = __builtin_amdgcn_rcpf(1.0f + __builtin_amdgcn_exp2f(__builtin_fmaf(ci[j], -1.44269504089f, cbi[n])));
                    const float a = __builtin_amdgcn_exp2f(csp[n] * r);
                    const float om = __builtin_fmaf(-a, a, 1.0f);
                    av[n][j] = a; bv[n][j] = __builtin_sqrtf(om) * gi * xcv[n][j];
                    Bp[n] = a * Bp[n] + bv[n][j]; Ap[n] *= a;
                }
            }
            float Aq[4][4], Bq[4][4];
#pragma unroll
            for (int n = 0; n < 4; ++n)
#pragma unroll
                for (int q2 = 0; q2 < 4; ++q2) { Aq[n][q2] = __shfl(Ap[n], fr + 16 * q2); Bq[n][q2] = __shfl(Bp[n], fr + 16 * q2); }
#pragma unroll
            for (int n = 0; n < 4; ++n) {
                float h = hin[n];
#pragma unroll
                for (int q2 = 0; q2 < 3; ++q2) { const float hq = Aq[n][q2] * h + Bq[n][q2]; h = (q2 < q) ? hq : h; }
                if (APPLY) {
#pragma unroll
                    for (int j = 0; j < 4; ++j) { h = av[n][j] * h + bv[n][j]; ybv[n][j] *= h; }
                }
                float he = hin[n];
#pragma unroll
                for (int q2 = 0; q2 < 4; ++q2) he = Aq[n][q2] * he + Bq[n][q2];
                hin[n] = he; pin[n] *= (Aq[n][0] * Aq[n][1]) * (Aq[n][2] * Aq[n][3]);
            }
            if (APPLY) {
#pragma unroll
                for (int n = 0; n < 4; ++n)
#pragma unroll
                    for (int j = 0; j < 4; ++j) *((LAS unsigned short*)(YBW + (4 * q + j) * 144) + 16 * n + fr) = (unsigned short)(cvt_pk_bf16(ybv[n][j], 0.f) & 0xffffu);
            }
            LDS_WAIT(); asm volatile("" ::: "memory");
        }
        if (APPLY) P2_GSTORE(nsc - 1, YBW0 + ((nsc - 1) & 1) * 2304);
        if (tid_prev >= 0) { const MoeItem m = moe_item(F, A, tid_prev); tr_finish(tv, m.WT, m.ldk, m.drow0, m.k0, trscr, lane); }
#undef P2_GSTORE
#undef P2_LOAD
        if (!APPLY && q == 0) { float* sp = scansum + (((size_t)(b * 16 + hd) * 32 + rho) * 64 + fr) * 2;
#pragma unroll
            for (int n = 0; n < 4; ++n) { sp[n * 32] = pin[n]; sp[n * 32 + 1] = hin[n]; } }
    }
}
constexpr int P4_WRF = 0, P4_LNG = 98304, P4_LNB = 102400, P4_LG = 106496  , P4_HIST = SMALL_OFF, P4_BASE = SMALL_OFF + 256;
__device__ __forceinline__ void p4_ln_route(const Frame& F, const Args& A, int layer, const bf16_t* y1, bf16_t* h1) {
    LAS unsigned char* L = F.lds;
    const int tid = F.tid, lane = F.lane, w = F.wave;
    const f32x2* stats = WSP(const f32x2, WS_STATS);
    int* list = WSP(int, WS_LIST); float* tokgate = WSP(float, WS_TOKGATE);
    unsigned* cnt = WSP(unsigned, WS_CTL) + CW_CNT + 64 * layer;
    const float* lng = A.in[21] + (size_t)(layer * 2 + 0) * D; const float* lnb = A.in[22] + (size_t)(layer * 2 + 0) * D;
    const float* bgrp = A.in[15] + layer * NG; const float* bexp = A.in[17] + layer * NE;
    const int gw = F.bid * 8 + w, NGW = F.G * 8;
    constexpr int NGR = TREAL / 16;
    const int fr = lane & 15, q = lane >> 4;
    f32x4 pa0 = (f32x4){0.f, 0.f, 0.f, 0.f}, pb0 = pa0; u32x4 ypre[8];
    { const int tok0 = (gw < NGR ? gw : 0) * 16 + fr;
      pa0 = *(const f32x4*)(stats + (size_t)tok0 * 16 + 4 * q); pb0 = *(const f32x4*)(stats + (size_t)tok0 * 16 + 4 * q + 2);
#pragma unroll
      for (int s2 = 0; s2 < 8; ++s2) ypre[s2] = *(const u32x4*)(y1 + (size_t)tok0 * D + 8 * q + 32 * s2); }
    __syncthreads();
    { const u32x4* src = (const u32x4*)(WSP(bf16_t, WS_WRF) + (size_t)layer * 49152);
      for (int p = tid; p < 6144; p += 512) *(LAS u32x4*)(L + P4_WRF + p * 16) = src[p];
      for (int p = tid; p < 256; p += 512) { *(LAS f32x4*)(L + P4_LNG + p * 16) = ((const f32x4*)lng)[p]; *(LAS f32x4*)(L + P4_LNB + p * 16) = ((const f32x4*)lnb)[p]; } }
    for (int p = F.bid * 512 + tid; p < (R - NTOK) * 128; p += F.G * 512) *(u32x4*)(h1 + (size_t)(NTOK + (p >> 7)) * D + (p & 127) * 8) = (u32x4){0u, 0u, 0u, 0u};
    LAS int* hist = (LAS int*)(L + P4_HIST); LAS int* basep = (LAS int*)(L + P4_BASE);
    LAS float* LG = (LAS float*)(L + P4_LG + w * 2048);
    const int niter = (NGR + NGW - 1) / NGW;
#pragma unroll 1
    for (int it = 0; it < niter; ++it) {
        __syncthreads();
        if (tid < 32) hist[tid] = 0;
        __syncthreads();
        int e0[2] = {0, 0}, e1[2] = {0, 0}, r0[2] = {0, 0}, r1[2] = {0, 0}; float g0[2] = {0.f, 0.f}, g1[2] = {0.f, 0.f}; int tokv[2] = {0, 0}; bool act[2] = {false, false};
#pragma unroll
        for (int gi = 0; gi < 2; ++gi) {
            const int grp = (gi == 0) ? (it * NGW + gw) : NGR;
            const bool active = (gi == 0) ? (grp < NGR) : (layer == 0 && it == 0 && gw == 0);
            act[gi] = active;
            const int tok = grp * 16 + fr; tokv[gi] = tok;
            if (active) {
                const bool first = (gi == 0 && it == 0);
                f32x4 pa = pa0, pb = pb0;
                if (!first) { pa = *(const f32x4*)(stats + (size_t)tok * 16 + 4 * q); pb = *(const f32x4*)(stats + (size_t)tok * 16 + 4 * q + 2); }
                float s1 = (pa[0] + pa[2]) + (pb[0] + pb[2]), s2 = (pa[1] + pa[3]) + (pb[1] + pb[3]);
                s1 += __shfl_xor(s1, 16); s1 += __shfl_xor(s1, 32); s2 += __shfl_xor(s2, 16); s2 += __shfl_xor(s2, 32);
                const float mu = s1 * (1.f / D), var = fmaxf(s2 * (1.f / D) - mu * mu, 0.f), rstd = __builtin_amdgcn_rsqf(var + LN_EPS);
                f32x4 acc[3];
#pragma unroll
                for (int k = 0; k < 3; ++k) acc[k] = (f32x4){0.f, 0.f, 0.f, 0.f};
                const bf16_t* yrow = y1 + (size_t)tok * D + 8 * q; bf16_t* hrow = h1 + (size_t)tok * D + 8 * q;
#pragma unroll 1
                for (int half = 0; half < 4; ++half) {
                    u32x4 yb[8];
                    if (half == 0 && first) {
#pragma unroll
                        for (int s2 = 0; s2 < 8; ++s2) yb[s2] = ypre[s2];
                    } else {
#pragma unroll
                        for (int s2 = 0; s2 < 8; ++s2) yb[s2] = *(const u32x4*)(yrow + 32 * (8 * half + s2));
                    }
#pragma unroll
                    for (int s2 = 0; s2 < 8; ++s2) {
                        const int s = 8 * half + s2;
                        float y[8], g[8], bb[8], h[8];
                        unpack8(yb[s2], y);
                        const int k0 = 32 * s + 8 * q;
                        { const f32x4 ga = *(const LAS f32x4*)(L + P4_LNG + k0 * 4), gb = *(const LAS f32x4*)(L + P4_LNG + k0 * 4 + 16);
                          const f32x4 ba = *(const LAS f32x4*)(L + P4_LNB + k0 * 4), bc = *(const LAS f32x4*)(L + P4_LNB + k0 * 4 + 16);
#pragma unroll
                          for (int j = 0; j < 4; ++j) { g[j] = ga[j]; g[4 + j] = gb[j]; bb[j] = ba[j]; bb[4 + j] = bc[j]; } }
#pragma unroll
                        for (int j = 0; j < 8; ++j) h[j] = (y[j] - mu) * rstd * g[j] + bb[j];
                        const u32x4 hw = pack8(h);
                        *(u32x4*)(hrow + 32 * s) = hw;
                        const bf16x8 hb = __builtin_bit_cast(bf16x8, hw);
#pragma unroll
                        for (int blk = 0; blk < 3; ++blk) { const bf16x8 wf = *(const LAS bf16x8*)(L + P4_WRF + ((s * 3 + blk) * 64 + lane) * 16);
                            acc[blk] = __builtin_amdgcn_mfma_f32_16x16x32_bf16(wf, hb, acc[blk], 0, 0, 0); }
                    }
                }
#pragma unroll
                for (int j = 0; j < 4; ++j) { LG[fr * 32 + 4 * q + j] = acc[1][j]; LG[fr * 32 + 16 + 4 * q + j] = acc[2][j]; }
                LDS_WAIT(); asm volatile("" ::: "memory");
                if (q == 0) {
                    float gl[4]; int g = 0; float gm = -3.4e38f;
#pragma unroll
                    for (int j = 0; j < 4; ++j) { gl[j] = acc[0][j] + bgrp[j]; if (gl[j] > gm) { gm = gl[j]; g = j; } }
                    float se = 0.f;
#pragma unroll
                    for (int j = 0; j < 4; ++j) se += __expf(gl[j] - gm);
                    const float pg = 1.f / se;
                    const f32x4 la = *(const LAS f32x4*)(LG + fr * 32 + 8 * g), lb = *(const LAS f32x4*)(LG + fr * 32 + 8 * g + 4);
                    const f32x4 ba = *(const f32x4*)(bexp + 8 * g), bc = *(const f32x4*)(bexp + 8 * g + 4);
                    float el[8];
#pragma unroll
                    for (int j = 0; j < 4; ++j) { el[j] = la[j] + ba[j]; el[4 + j] = lb[j] + bc[j]; }
                    int i0 = -1, i1 = -1; float v0 = -3.4e38f, v1 = -3.4e38f;
#pragma unroll
                    for (int j = 0; j < 8; ++j) { const float v = el[j];
                        if (v > v0) { v1 = v0; i1 = i0; v0 = v; i0 = j; } else if (v > v1) { v1 = v; i1 = j; } }
                    const float ex = __expf(v1 - v0);
                    const float p0 = 1.f / (1.f + ex);
                    g0[gi] = pg * p0; g1[gi] = pg * (ex * p0);
                    e0[gi] = g * 8 + i0; e1[gi] = g * 8 + i1;
                    r0[gi] = __hip_atomic_fetch_add(&hist[e0[gi]], 1, __ATOMIC_RELAXED, __HIP_MEMORY_SCOPE_WORKGROUP); r1[gi] = __hip_atomic_fetch_add(&hist[e1[gi]], 1, __ATOMIC_RELAXED, __HIP_MEMORY_SCOPE_WORKGROUP);
                }
                LDS_WAIT(); asm volatile("" ::: "memory");
            }
        }
        __syncthreads();
        if (tid < 32) { const int hcnt = hist[tid]; basep[tid] = hcnt ? (int)__hip_atomic_fetch_add(cnt + tid, (unsigned)hcnt, RLX_AGENT) : 0; }
        __syncthreads();
#pragma unroll
        for (int gi = 0; gi < 2; ++gi) if (act[gi] && q == 0) {
            const int p0 = basep[e0[gi]] + r0[gi], p1 = basep[e1[gi]] + r1[gi];
            list[e0[gi] * CAP + p0] = 2 * tokv[gi]; list[e1[gi] * CAP + p1] = 2 * tokv[gi] + 1;
            tokgate[2 * tokv[gi]] = g0[gi]; tokgate[2 * tokv[gi] + 1] = g1[gi];
        }
    }
}

__device__ __forceinline__ int moe_tables(const Frame& F, int layer) {
    LAS int* tbl = (LAS int*)(F.lds + SMALL_OFF + 1024);
    const unsigned* cnt = WSP(const unsigned, WS_CTL) + CW_CNT + 64 * layer;
    __syncthreads();
    if (F.tid < 32) tbl[F.tid] = (int)__hip_atomic_load(cnt + F.tid, RLX_AGENT);
    __syncthreads();
    if (F.tid == 0) { int s = 0; for (int e = 0; e < NE; ++e) { tbl[32 + e] = s; s += (tbl[e] + 255) >> 8; } tbl[64] = s; }
    __syncthreads();
    return 4 * tbl[64];
}

template <bool FINAL>
__device__ __forceinline__ void p7_combine(const Frame& F, const Args& A, int layer, const bf16_t* h1, const bf16_t* cbuf, bf16_t* h2, float* out) {
    const int lane = F.lane, gw = F.bid * 8 + F.wave, NGW = F.G * 8;
    const float* lng = A.in[21] + (size_t)(layer * 2 + 1) * D; const float* lnb = A.in[22] + (size_t)(layer * 2 + 1) * D;
    float g[16], bb[16];
#pragma unroll
    for (int hx = 0; hx < 2; ++hx) { const int c0 = hx * 512 + lane * 8;
        const f32x4 ga = *(const f32x4*)(lng + c0), gb = *(const f32x4*)(lng + c0 + 4), ba = *(const f32x4*)(lnb + c0), bc = *(const f32x4*)(lnb + c0 + 4);
#pragma unroll
        for (int j = 0; j < 4; ++j) { g[hx * 8 + j] = ga[j]; g[hx * 8 + 4 + j] = gb[j]; bb[hx * 8 + j] = ba[j]; bb[hx * 8 + 4 + j] = bc[j]; } }
    const int ntok = FINAL ? TREAL : NTOK;
#pragma unroll 2
    for (int t = gw; t < ntok; t += NGW) {
        float y[16];
#pragma unroll
        for (int hx = 0; hx < 2; ++hx) { const int c0 = hx * 512 + lane * 8;
            float a[8], c0v[8], c1v[8];
            unpack8(__builtin_nontemporal_load((const u32x4*)(h1 + (size_t)t * D + c0)), a);
            unpack8(__builtin_nontemporal_load((const u32x4*)(cbuf + (size_t)(2 * t) * D + c0)), c0v);
            unpack8(__builtin_nontemporal_load((const u32x4*)(cbuf + (size_t)(2 * t + 1) * D + c0)), c1v);
#pragma unroll
            for (int j = 0; j < 8; ++j) y[hx * 8 + j] = ALPHA * a[j] + (c0v[j] + c1v[j]); }
        float s = 0.f;
#pragma unroll
        for (int j = 0; j < 16; ++j) s += y[j];
        const float mu = wave_sum(s) * (1.f / D);
        float qv = 0.f;
#pragma unroll
        for (int j = 0; j < 16; ++j) { y[j] -= mu; qv += y[j] * y[j]; }
        const float rstd = __builtin_amdgcn_rsqf(wave_sum(qv) * (1.f / D) + LN_EPS);
#pragma unroll
        for (int j = 0; j < 16; ++j) y[j] = y[j] * rstd * g[j] + bb[j];
#pragma unroll
        for (int hx = 0; hx < 2; ++hx) { const int c0 = hx * 512 + lane * 8;
            if (FINAL) { __builtin_nontemporal_store((f32x4){y[hx * 8 + 0], y[hx * 8 + 1], y[hx * 8 + 2], y[hx * 8 + 3]}, (f32x4*)(out + (size_t)t * D + c0));
                         __builtin_nontemporal_store((f32x4){y[hx * 8 + 4], y[hx * 8 + 5], y[hx * 8 + 6], y[hx * 8 + 7]}, (f32x4*)(out + (size_t)t * D + c0 + 4)); }
            else { float o[8];
#pragma unroll
                for (int j = 0; j < 8; ++j) o[j] = y[hx * 8 + j];
                *(u32x4*)(h2 + (size_t)t * D + c0) = pack8(o); } }
    }
}

__device__ __forceinline__ void p9_convgate(const Frame& F, const Args& A, const bf16_t* bg, const bf16_t* z, bf16_t* g1) {
    const float* cw = A.in[12];
    const int gt = F.bid * 512 + F.tid, NT = F.G * 512;
    for (int item = gt; item < (TREAL / 16) * 128; item += NT) {
        const int pc = item & 127, run = item >> 7, r0 = run * 16, c0 = pc * 8;
        float w0[8], w1[8], w2[8];
        { const f32x4 a = *(const f32x4*)(cw + c0), b = *(const f32x4*)(cw + c0 + 4), c = *(const f32x4*)(cw + D + c0), d = *(const f32x4*)(cw + D + c0 + 4), e = *(const f32x4*)(cw + 2 * D + c0), f = *(const f32x4*)(cw + 2 * D + c0 + 4);
#pragma unroll
          for (int j = 0; j < 4; ++j) { w0[j] = a[j]; w0[4 + j] = b[j]; w1[j] = c[j]; w1[4 + j] = d[j]; w2[j] = e[j]; w2[4 + j] = f[j]; } }
        const bool first = (r0 & (SEQ - 1)) == 0;
        const size_t rm1 = first ? (size_t)(TREAL + NMETA - 1) : (size_t)(r0 - 1), rm2 = first ? (size_t)(TREAL + NMETA - 2) : (size_t)(r0 - 2);
        float z1[8], z2[8];
        unpack8(*(const u32x4*)(z + rm1 * D + c0), z1); unpack8(*(const u32x4*)(z + rm2 * D + c0), z2);
#pragma unroll 4
        for (int j = 0; j < 16; ++j) {
            float z0[8], b[8], o[8];
            unpack8(__builtin_nontemporal_load((const u32x4*)(z + (size_t)(r0 + j) * D + c0)), z0); unpack8(__builtin_nontemporal_load((const u32x4*)(bg + (size_t)(r0 + j) * D + c0)), b);
#pragma unroll
            for (int i = 0; i < 8; ++i) { o[i] = b[i] * (w0[i] * z2[i] + w1[i] * z1[i] + w2[i] * z0[i]); z2[i] = z1[i]; z1[i] = z0[i]; }
            *(u32x4*)(g1 + (size_t)(r0 + j) * D + c0) = pack8(o);
        }
    }
}

template <int NT> __device__ __forceinline__ void meta_partials(const Frame& F, const bf16_t* a16, const bf16_t* wt, const int (&n0)[NT]) {
    const int lane = F.lane, fr = lane & 15, q = lane >> 4, w = F.wave;
    const bf16_t* ap = a16 + (size_t)fr * D + 8 * q + 128 * w;
    bf16x8 af[4], bfr[NT][4];
#pragma unroll
    for (int s = 0; s < 4; ++s) af[s] = *(const bf16x8*)(ap + 32 * s);
#pragma unroll
    for (int t = 0; t < NT; ++t) { const bf16_t* bp = wt + (size_t)(n0[t] + fr) * D + 8 * q + 128 * w;
#pragma unroll
        for (int s = 0; s < 4; ++s) bfr[t][s] = *(const bf16x8*)(bp + 32 * s); }
#pragma unroll
    for (int t = 0; t < NT; ++t) { f32x4 acc = (f32x4){0.f, 0.f, 0.f, 0.f};
#pragma unroll
        for (int s = 0; s < 4; ++s) acc = __builtin_amdgcn_mfma_f32_16x16x32_bf16(af[s], bfr[t][s], acc, 0, 0, 0);
        *(LAS f32x4*)(F.lds + ((w * NT + t) * 64 + lane) * 16) = acc; }
    __syncthreads();
}
template <int NT> __device__ __forceinline__ f32x4 meta_reduce(const Frame& F, int t) {
    f32x4 acc = (f32x4){0.f, 0.f, 0.f, 0.f};
#pragma unroll
    for (int w = 0; w < 8; ++w) acc += *(const LAS f32x4*)(F.lds + ((w * NT + t) * 64 + F.lane) * 16);
    return acc;
}
__device__ __forceinline__ bf16_t bf16_of(float v) { return (bf16_t)(cvt_pk_bf16(v, 0.f) & 0xffffu); }
__device__ __forceinline__ void meta_in0(const Frame& F) {
    const int g = F.bid; if (g >= 32) return;
    const int lane = F.lane, fr = lane & 15, q = lane >> 4;
    const int n0[4] = {g * 64, g * 64 + 16, g * 64 + 32, g * 64 + 48};
    __syncthreads();
    meta_partials<4>(F, WSP(const bf16_t, WS_RA) + (size_t)TREAL * D, WSP(const bf16_t, WS_WIN0), n0);
    if (F.wave < 4) { const int t = F.wave; const f32x4 acc = meta_reduce<4>(F, t);
        const bool left = g < 16; bf16_t* base = left ? WSP(bf16_t, WS_RB) : WSP(bf16_t, WS_RC);
#pragma unroll
        for (int j = 0; j < 4; ++j) { const float v = left ? gelu_tanh_f(acc[j]) : acc[j]; base[(size_t)(TREAL + 4 * q + j) * D + (((g * 64) & 1023) + 16 * t + fr)] = bf16_of(v); } }
    __syncthreads();
}
__device__ __forceinline__ void meta_out0(const Frame& F, const Args& A) {
    const int g = F.bid; if (g >= 16) return;
    const int lane = F.lane, fr = lane & 15, q = lane >> 4;
    const int n0[4] = {g * 64, g * 64 + 16, g * 64 + 32, g * 64 + 48};
    __syncthreads();
    meta_partials<4>(F, WSP(const bf16_t, WS_RA) + (size_t)TREAL * D, WSP(const bf16_t, WS_WOUT0), n0);
    LAS float* sp = (LAS float*)(F.lds + 65536);
    if (F.wave < 4) { const int t = F.wave; const f32x4 acc = meta_reduce<4>(F, t);
        bf16_t* y1 = WSP(bf16_t, WS_RB);
#pragma unroll
        for (int j = 0; j < 4; ++j) { const int m = 4 * q + j; const int col = g * 64 + 16 * t + fr;
            const float v = acc[j] + ALPHA * A.in[1][(size_t)m * D + col]; float s1 = v, s2 = v * v;
            y1[(size_t)(TREAL + m) * D + col] = bf16_of(v);
#pragma unroll
            for (int o = 1; o < 16; o <<= 1) { s1 += __shfl_xor(s1, o); s2 += __shfl_xor(s2, o); }
            if (fr == 0) { sp[(t * 16 + m) * 2] = s1; sp[(t * 16 + m) * 2 + 1] = s2; } } }
    __syncthreads();
    if (F.tid < 16) { const int m = F.tid; float s1 = 0.f, s2 = 0.f;
#pragma unroll
        for (int t = 0; t < 4; ++t) { s1 += sp[(t * 16 + m) * 2]; s2 += sp[(t * 16 + m) * 2 + 1]; }
        WSP(f32x2, WS_STATS)[(size_t)(TREAL + m) * 16 + g] = (f32x2){s1, s2}; }
    __syncthreads();
}
__device__ __forceinline__ void meta_in1(const Frame& F) {
    const int g = F.bid; if (g >= 16) return;
    const int lane = F.lane, fr = lane & 15, q = lane >> 4;
    const int zc0 = g * 64;
    const int r0 = 1024 + 256 * (zc0 >> 7) + (zc0 & 127);
    const int n0[8] = {r0, r0 + 16, r0 + 32, r0 + 48, r0 + 128, r0 + 144, r0 + 160, r0 + 176};
    __syncthreads();
    meta_partials<8>(F, WSP(const bf16_t, WS_RA) + (size_t)TREAL * D, WSP(const bf16_t, WS_WIN1), n0);
    if (F.wave < 4) { const int t = F.wave; const f32x4 cg = meta_reduce<8>(F, t), vv = meta_reduce<8>(F, 4 + t);
        bf16_t* z = WSP(bf16_t, WS_RC);
#pragma unroll
        for (int j = 0; j < 4; ++j) z[(size_t)(TREAL + 4 * q + j) * D + zc0 + 16 * t + fr] = bf16_of(cg[j] * vv[j]); }
    __syncthreads();
}
#define XB_TMO      128
#define XB_XCNT(j)  (256  + 64 * (j))
#define XB_XSUB(j)  (1280 + 64 * (j))
#define XB_XGEN(j)  (2304 + 64 * (j))
#define XB_TOP      3328
#define XB_TOPGEN   3392
#define XCD_BAR_WORDS 3456
#define XB_SPIN_CAP (1u << 20)
__device__ __forceinline__ unsigned xb_ld(unsigned* p)              { return __hip_atomic_load(p, __ATOMIC_RELAXED, __HIP_MEMORY_SCOPE_AGENT); }
__device__ __forceinline__ unsigned xb_add(unsigned* p, unsigned v) { return __hip_atomic_fetch_add(p, v, __ATOMIC_RELAXED, __HIP_MEMORY_SCOPE_AGENT); }
__device__ __forceinline__ unsigned xb_xcc_id() { return (unsigned)__builtin_amdgcn_s_getreg((3 << 11) | 20) & 0xFu; }
#define XB_SPIN(cond, bar) do { unsigned _sp = 0; while (cond) { __builtin_amdgcn_s_sleep(1); \
    if ((++_sp & 255u) == 0u) { if (xb_ld(&(bar)[XB_TMO])) break; if (_sp > XB_SPIN_CAP) { atomicAdd(&(bar)[XB_TMO], 1u); break; } } } } while (0)
struct XcdBarrier { unsigned* bar; unsigned x; volatile LAS unsigned* st; };
__device__ __forceinline__ XcdBarrier xcd_barrier_post(unsigned* bar, volatile LAS unsigned* st) {
    XcdBarrier b; b.bar = bar; b.x = xb_xcc_id(); b.st = st;
    if (threadIdx.x == 0) (void)xb_add(&bar[XB_XCNT(b.x)], 1u);
    return b;
}
__device__ __forceinline__ void xcd_barrier_complete(unsigned* bar, unsigned x, unsigned& nloc, unsigned& nx) {
    const unsigned G = gridDim.x * gridDim.y * gridDim.z;
    unsigned sum, cnt, mine, sp = 0u;
    for (;;) {
        sum = 0u; cnt = 0u; mine = 0u;
#pragma unroll
        for (unsigned j = 0; j < 16; ++j) { const unsigned c = xb_ld(&bar[XB_XCNT(j)]); sum += c; cnt += (c > 0u) ? 1u : 0u; mine = (j == x) ? c : mine; }
        if (sum == G) break;
        __builtin_amdgcn_s_sleep(1);
        if ((++sp & 255u) == 0u) { if (xb_ld(&bar[XB_TMO])) break; if (sp > XB_SPIN_CAP) { atomicAdd(&bar[XB_TMO], 1u); break; } }
    }
    nloc = mine > 0u ? mine : 1u; nx = cnt > 0u ? cnt : 1u;
}
__device__ __forceinline__ void xcd_barrier(const XcdBarrier& b) {
    asm volatile("s_waitcnt vmcnt(0)" ::: "memory");
    __syncthreads();
    if (threadIdx.x == 0) {
        unsigned* bar = b.bar;
        __builtin_amdgcn_s_waitcnt(0);
        unsigned nloc = b.st[0], nx = b.st[1];
        if (nloc == 0u) { xcd_barrier_complete(bar, b.x, nloc, nx); b.st[0] = nloc; b.st[1] = nx; }
        const unsigned old = xb_add(&bar[XB_XSUB(b.x)], 1u);
        const unsigned gen = old / nloc;
        if (old + 1u == (gen + 1u) * nloc) {
            __builtin_amdgcn_fence(__ATOMIC_RELEASE, "agent");
            asm volatile("s_waitcnt vmcnt(0)" ::: "memory");
            const unsigned og = xb_add(&bar[XB_TOP], 1u);
            const unsigned tg = og / nx;
            if (og + 1u == (tg + 1u) * nx) xb_add(&bar[XB_TOPGEN], 1u);
            else XB_SPIN(xb_ld(&bar[XB_TOPGEN]) == tg, bar);
            __builtin_amdgcn_fence(__ATOMIC_ACQUIRE, "agent");
            xb_add(&bar[XB_XGEN(b.x)], 1u);
            asm volatile("s_waitcnt vmcnt(0)" ::: "memory");
        } else {
            XB_SPIN(xb_ld(&bar[XB_XGEN(b.x)]) == gen, bar);
            __builtin_amdgcn_fence(__ATOMIC_ACQUIRE, "agent");
            asm volatile("s_waitcnt vmcnt(0)" ::: "memory");
        }
    }
    __syncthreads();
}

constexpr int DBG_NS = 4096, DBG_SLOTS = 16;
__host__ __device__ __forceinline__ void dbg_rc(int i, int nrows, int& r, int& c) {
    const unsigned h = (unsigned)i * 2654435761u;
    c = (int)((h >> 9) & 1023u);
    if (i < 64) { const int sp[8] = {0, 1, 2, 8192, 8193, 32768, 32783, 32767}; r = sp[i & 7] % nrows; }
    else r = (int)(((unsigned)i * 40503u + (h >> 20)) % (unsigned)nrows);
}
__device__ __forceinline__ void dbg_sample_bf16(const Frame& F, int slot, const bf16_t* buf, int nrows) {
    float* dg = (float*)(F.ws + WS_DIGEST) + (size_t)slot * DBG_NS;
    for (int i = F.bid * 512 + F.tid; i < DBG_NS; i += F.G * 512) { int r, c; dbg_rc(i, nrows, r, c); dg[i] = bf1(buf[(size_t)r * D + c]); }
}
__device__ __forceinline__ void dbg_sample_c(const Frame& F, int slot, const bf16_t* cbuf, int nrows = NTOK) {
    float* dg = (float*)(F.ws + WS_DIGEST) + (size_t)slot * DBG_NS;
    for (int i = F.bid * 512 + F.tid; i < DBG_NS; i += F.G * 512) { int r, c; dbg_rc(i, nrows, r, c); dg[i] = bf1(cbuf[(size_t)(2 * r + (i & 1)) * D + c]); }
}
__device__ __forceinline__ void dbg_sample_gate(const Frame& F, int slot, int nrows = NTOK) {
    float* dg = (float*)(F.ws + WS_DIGEST) + (size_t)slot * DBG_NS; const float* tg = (const float*)(F.ws + WS_TOKGATE);
    for (int i = F.bid * 512 + F.tid; i < DBG_NS; i += F.G * 512) { int r, c; dbg_rc(i, nrows, r, c); dg[i] = tg[2 * r + (i & 1)]; }
}

#ifndef MK_SKEW_NS
#define MK_SKEW_NS 0
#endif
__device__ __forceinline__ void gemm_skew(const Frame& F) {
    if (MK_SKEW_NS > 0) { const unsigned long long t0 = __builtin_amdgcn_s_memrealtime(); const unsigned long long d = (unsigned long long)((F.bid >> 6) & 3) * (MK_SKEW_NS / 10);
        while (__builtin_amdgcn_s_memrealtime() - t0 < d) __builtin_amdgcn_s_sleep(4); }
}
__global__ void __launch_bounds__(512, 2) mk_fwd(Args args) {
    extern __shared__ __attribute__((aligned(16))) unsigned char lds_raw[];
    Frame F;
    F.lds = (LAS unsigned char*)lds_raw;
    F.tid = threadIdx.x; F.lane = F.tid & 63; F.wave = __builtin_amdgcn_readfirstlane(F.tid >> 6);
    F.G = gridDim.x; F.bid = blockIdx.x;
    F.ws = args.ws;
    volatile LAS unsigned* MISC = (volatile LAS unsigned*)(F.lds + MISC_OFF);
    if (F.tid < 64) MISC[F.tid] = 0u;
    __syncthreads();
    XcdBarrier bar; bar.bar = (unsigned*)(F.ws + WS_CTL) + CW_BAR; bar.x = 0; bar.st = nullptr;
    if (MK_N_LAUNCHES == 1) bar = xcd_barrier_post((unsigned*)(F.ws + WS_CTL) + CW_BAR, MISC + 8);
    const int lo = args.ph_lo, hi = args.ph_hi;
#ifndef MK_TIME_PHASE
#define MK_TIME_PHASE -1
#endif
    volatile LAS unsigned long long* STAMP = (volatile LAS unsigned long long*)(F.lds + MISC_OFF + 1024);
#define STAMP_AT(k) do { if (MK_TIME_PHASE >= 0 && F.bid == 0 && F.tid == 0) STAMP[k] = __builtin_amdgcn_s_memrealtime(); } while (0)
    STAMP_AT(0);
#define IN(k) (lo <= (k) && (k) < hi)
#ifndef MK_EXTRA_BAR
#define MK_EXTRA_BAR 0
#endif
#define SEAM(k) do { if (IN(k) && IN((k) + 1)) { for (int xb_ = 0; xb_ <= MK_EXTRA_BAR; ++xb_) xcd_barrier(bar); } STAMP_AT((k) + 1); } while (0)
#ifndef MK_REP_MASK
#define MK_REP_MASK 0
#endif
#define REPS(k) for (int rep_ = 0; rep_ < 1 + ((MK_REP_MASK >> (k)) & 1); ++rep_, (void)((rep_ < 1 + ((MK_REP_MASK >> (k)) & 1)) ? (xcd_barrier(bar), 0) : 0))
    bf16_t* RA = WSP(bf16_t, WS_RA); bf16_t* RBb = WSP(bf16_t, WS_RB); bf16_t* RC = WSP(bf16_t, WS_RC); bf16_t* RE = WSP(bf16_t, WS_RE);
    LAS int* tbl = (LAS int*)(F.lds + SMALL_OFF + 1024);

    if (IN(0)) REPS(0) { p0_prologue(F, args); } SEAM(0);
    if (IN(1)) REPS(1) {
        meta_in0(F);
        ProbIn0 P; P.Abase = (const char*)RA; P.ord.init(TREAL / 256, 8, F.G, F.bid); P.Bt = (const char*)(F.ws + WS_WIN0); P.ybr = RBb; P.xraw = RC;
        gemm_skew(F); pg8::gemm_phase(F.lds, P);
    } SEAM(1);
    if (IN(2)) REPS(2) { if (MK_DEBUG_ORACLE) { dbg_sample_bf16(F, 0, RBb, NTOK); dbg_sample_bf16(F, 1, RC, NTOK); } p2_lru<false>(F, args); } SEAM(2);
    if (IN(3)) REPS(3) { p2_lru<true>(F, args); } SEAM(3);
    if (IN(4)) REPS(4) {
        if (MK_DEBUG_ORACLE) dbg_sample_bf16(F, 2, RA, NTOK);
        meta_out0(F, args);
        ProbOut<true> P; P.Abase = (const char*)RA; P.ord.init(TREAL / 256, 4, F.G, F.bid); P.Bt = (const char*)(F.ws + WS_WOUT0); P.y1 = RBb; P.stats = WSP(f32x2, WS_STATS);
        P.x = args.in[0]; P.meta = args.in[1]; P.hres = nullptr;
        gemm_skew(F); pg8::gemm_phase(F.lds, P);
    } SEAM(4);
    if (IN(5)) REPS(5) { if (MK_DEBUG_ORACLE) dbg_sample_bf16(F, 3, RBb, NTOK); p4_ln_route(F, args, 0, RBb, RC); } SEAM(5);
    if (IN(6)) REPS(6) {
        if (MK_DEBUG_ORACLE) { dbg_sample_bf16(F, 4, RC, NTOK); dbg_sample_gate(F, 5); }
        const int total = moe_tables(F, 0);
        ProbUp P; P.Abase = (const char*)RC; P.ord.tbl = tbl; P.ord.c = F.bid; P.ord.total = total; P.gu = (const char*)(F.ws + WS_GU); P.list = WSP(const int, WS_LIST); P.hid = RA; P.mcnt = WSP(unsigned, WS_CTL) + CW_MOE;
        gemm_skew(F); pg8::gemm_phase(F.lds, P);
    }
SEAM(6);
    if (IN(7)) REPS(7) {
        const int total = moe_tables(F, 0);
        ProbDown P; P.Abase = (const char*)RA; P.ord.tbl = tbl; P.ord.c = F.bid; P.ord.total = total; P.dn = (const char*)(F.ws + WS_DN); P.list = WSP(const int, WS_LIST); P.tokgate = WSP(const float, WS_TOKGATE); P.cbuf = RE; P.mcnt = WSP(unsigned, WS_CTL) + CW_MOE; P.tmo = WSP(unsigned, WS_CTL) + CW_TMO;
        gemm_skew(F); pg8::gemm_phase(F.lds, P);
    } SEAM(7);
    if (IN(8)) REPS(8) {
        if (MK_DEBUG_ORACLE) dbg_sample_c(F, 6, RE);
#ifndef MK_SUBREP
#define MK_SUBREP 0
#endif
        for (int sr_ = 0; sr_ < ((MK_SUBREP == 1) ? 2 : 1); ++sr_) p7_combine<false>(F, args, 0, RC, RE, RA, nullptr);
    } SEAM(8);
    if (IN(9)) REPS(9) {
        if (MK_DEBUG_ORACLE) dbg_sample_bf16(F, 7, RA, NTOK);
        meta_in1(F);
        ProbIn1 P; P.Abase = (const char*)RA; P.ord.init(TREAL / 256, 12, F.G, F.bid); P.Bt = (const char*)(F.ws + WS_WIN1); P.bg = RBb; P.z = RC;
#ifndef MK_EPI_PROBE
#define MK_EPI_PROBE 0
#endif
        gemm_skew(F); pg8::gemm_phase(F.lds, P, MK_EPI_PROBE);
    } SEAM(9);
    if (IN(10)) REPS(10) { if (MK_DEBUG_ORACLE) { dbg_sample_bf16(F, 8, RBb, TREAL); dbg_sample_bf16(F, 9, RC, NTOK); } p9_convgate(F, args, RBb, RC, RE); } SEAM(10);
    if (IN(11)) REPS(11) {
        if (MK_DEBUG_ORACLE) dbg_sample_bf16(F, 10, RE, TREAL);
        ProbOut<false> P; P.Abase = (const char*)RE; P.ord.init(TREAL / 256, 4, F.G, F.bid); P.Bt = (const char*)(F.ws + WS_WOUT1); P.y1 = RBb; P.stats = WSP(f32x2, WS_STATS);
        P.x = nullptr; P.meta = nullptr; P.hres = RA;
        gemm_skew(F); pg8::gemm_phase(F.lds, P);
    } SEAM(11);
    if (IN(12)) REPS(12) { if (MK_DEBUG_ORACLE) dbg_sample_bf16(F, 11, RBb, TREAL); p4_ln_route(F, args, 1, RBb, RC); } SEAM(12);
    if (IN(13)) REPS(13) {
        if (MK_DEBUG_ORACLE) { dbg_sample_bf16(F, 12, RC, TREAL); dbg_sample_gate(F, 13, TREAL); }
        const int total = moe_tables(F, 1);
        ProbUp P; P.Abase = (const char*)RC; P.ord.tbl = tbl; P.ord.c = F.bid; P.ord.total = total; P.gu = (const char*)(F.ws + WS_GU1); P.list = WSP(const int, WS_LIST); P.hid = RA; P.mcnt = WSP(unsigned, WS_CTL) + CW_MOE + 32768;
        gemm_skew(F); pg8::gemm_phase(F.lds, P);
    }
SEAM(13);
    if (IN(14)) REPS(14) {
        const int total = moe_tables(F, 1);
        ProbDown P; P.Abase = (const char*)RA; P.ord.tbl = tbl; P.ord.c = F.bid; P.ord.total = total; P.dn = (const char*)(F.ws + WS_DN1); P.list = WSP(const int, WS_LIST); P.tokgate = WSP(const float, WS_TOKGATE); P.cbuf = RE; P.mcnt = WSP(unsigned, WS_CTL) + CW_MOE + 32768; P.tmo = WSP(unsigned, WS_CTL) + CW_TMO;
        gemm_skew(F); pg8::gemm_phase(F.lds, P);
    } SEAM(14);
    if (IN(15)) REPS(15) { if (MK_DEBUG_ORACLE) dbg_sample_c(F, 14, RE, TREAL); p7_combine<true>(F, args, 1, RC, RE, nullptr, args.out); }
    if (MK_TIME_PHASE >= 0 && F.bid == 0 && F.tid == 0) {
        STAMP[16] = __builtin_amdgcn_s_memrealtime();
        const unsigned long long T = MK_EPI_PROBE ? STAMP[20] : (STAMP[MK_TIME_PHASE + 1] - STAMP[MK_TIME_PHASE]);
        const unsigned long long t0 = __builtin_amdgcn_s_memrealtime();
        while (__builtin_amdgcn_s_memrealtime() - t0 < 4ull * T) __builtin_amdgcn_s_sleep(8);
    }
#undef IN
#undef SEAM
}
#if MK_DEBUG_ORACLE
static void dbg_oracle(void* const* d_in, void* d_out, void* d_ws, hipStream_t st);
#endif
extern "C" void kernel_launch(void* const* d_in, const int* in_sizes, int n_in, void* d_out, int out_size, void* d_ws, size_t ws_size, hipStream_t stream) {
    static int grid = 0;
    if (grid == 0) {
        int dev = 0, cus = 0;
        if (hipGetDevice(&dev) != hipSuccess || hipDeviceGetAttribute(&cus, hipDeviceAttributeMultiprocessorCount, dev) != hipSuccess) { fprintf(stderr, "kernel_launch: device query failed\n"); grid = -1; return; }
        if (hipFuncSetAttribute((const void*)mk_fwd, hipFuncAttributeMaxDynamicSharedMemorySize, LDS_BYTES) != hipSuccess) { fprintf(stderr, "kernel_launch: hipFuncSetAttribute failed\n"); grid = -1; return; }
        int per_cu = 0;
        if (hipOccupancyMaxActiveBlocksPerMultiprocessor(&per_cu, (const void*)mk_fwd, 512, LDS_BYTES) != hipSuccess || per_cu < 1) fprintf(stderr, "kernel_launch: occupancy query reports %d blocks per CU\n", per_cu);
        (void)hipGetLastError();
        grid = cus;
        if (n_in != 23 || ws_size < WS_END2) fprintf(stderr, "kernel_launch: unexpected n_in %d / ws_size %zu (need %zu)\n", n_in, ws_size, (size_t)WS_END2);
    }
    if (grid < 0) return;
    (void)hipMemsetAsync((char*)d_ws + WS_CTL, 0, CTL_ZERO_BYTES, stream);
    Args a{};
    for (int i = 0; i < 23; ++i) a.in[i] = (const float*)d_in[i];
    a.out = (float*)d_out; a.ws = (unsigned char*)d_ws;
    if (MK_N_LAUNCHES == 1) {
        a.ph_lo = 0; a.ph_hi = 16;
        hipLaunchKernelGGL(mk_fwd, dim3(grid), dim3(512), LDS_BYTES, stream, a);
    } else {
        for (int p = 0; p < 16; ++p) { a.ph_lo = p; a.ph_hi = p + 1; hipLaunchKernelGGL(mk_fwd, dim3(grid), dim3(512), LDS_BYTES, stream, a); }
    }
#if MK_DEBUG_ORACLE
    dbg_oracle(d_in, d_out, d_ws, stream);
#endif
}
```
